# Optimizing an MI355X kernel written in HIP

```python
import jax
import jax.numpy as jnp
from jax import lax
import numpy as np

D_MODEL = 2048
BATCH = 8
SEQ = 4096
DEPTH = 4
DEC_BATCH = 1
DEC_SEQ = 16384
PAST_LEN = 128

HEAD_DIM = 128
LRU_WIDTH = 512
LRU_BLOCKS = 4
CONV_WIDTH = 4
CONV_LEFT = 2
LRU_C = 8.0
DIL_HEADS = 6
DIL_PATTERNS = ((128, 1), (512, 4), (2048, 16))
SWA_HEADS = 6
SWA_KV_HEADS = 2
SWA_WINDOW = 128
DIL_WIDTH = DIL_HEADS * HEAD_DIM
SWA_WIDTH = SWA_HEADS * HEAD_DIM
SWA_KV_WIDTH = SWA_KV_HEADS * HEAD_DIM
MIX_WIDTH = LRU_WIDTH + DIL_WIDTH + SWA_WIDTH
IN_SPLITS = tuple(int(c) for c in np.cumsum([LRU_WIDTH, LRU_WIDTH, DIL_WIDTH, DIL_WIDTH, DIL_WIDTH, SWA_WIDTH, SWA_KV_WIDTH]))
IN_WIDTH = IN_SPLITS[-1] + SWA_KV_WIDTH
GROUP_SPLITS = (LRU_WIDTH, LRU_WIDTH + DIL_WIDTH)
N_MEM = 256
MEM_HEADS = 4
MEM_WIDTH = MEM_HEADS * HEAD_DIM
D_FF = 4 * D_MODEL
EPS = 1e-6

kernel_name = 'hybrid_bidir_encoder_parallel_groups'


def rms_norm(x, g):
    xf = x.astype(jnp.float32)
    y = xf * lax.rsqrt(jnp.mean(xf * xf, axis=-1, keepdims=True) + EPS)
    return (y * g.astype(jnp.float32)).astype(x.dtype)


def alibi_slopes(n):
    return jnp.asarray([2.0 ** (-8.0 * (i + 1) / n) for i in range(n)], dtype=jnp.float32)


def banded_attention(q, k, v, window, dist_scale, slopes):
    b, L, hq, dh = q.shape
    hkv = k.shape[2]
    rep = hq // hkv
    w = window
    nb = -(-L // w)
    lp = nb * w
    qb = jnp.pad(q, ((0, 0), (0, lp - L), (0, 0), (0, 0))).reshape(b, nb, w, hkv, rep, dh)
    pad_kv = ((0, 0), (w, lp - L + w), (0, 0), (0, 0))

    def key_blocks(t):
        tp = jnp.pad(t, pad_kv)
        return jnp.concatenate([tp[:, o * w:o * w + lp].reshape(b, nb, w, hkv, dh) for o in range(3)], axis=2)

    kb = key_blocks(k)
    vb = key_blocks(v)
    scores = jnp.einsum('bnqgrd,bnkgd->bngrqk', qb, kb, preferred_element_type=jnp.float32) * (dh ** -0.5)
    qi = jnp.arange(w)[:, None]
    kj = jnp.arange(3 * w)[None, :]
    rel = kj - w - qi
    k_pos = jnp.arange(nb)[:, None, None] * w + kj[None] - w
    valid = (jnp.abs(rel)[None] <= w) & (k_pos >= 0) & (k_pos < L)
    dist = (dist_scale * jnp.abs(rel)).astype(jnp.float32)
    bias = -slopes.reshape(hkv, rep)[:, :, None, None] * dist[None, None]
    logits = jnp.where(valid[None, :, None, None], scores + bias[None, None], -jnp.inf)
    m = jnp.max(logits, axis=-1)
    p = jnp.exp(logits - m[..., None])
    s = jnp.sum(p, axis=-1)
    o = jnp.einsum('bngrqk,bnkgd->bnqgrd', p.astype(v.dtype), vb, preferred_element_type=jnp.float32)
    o = o / s.transpose(0, 1, 4, 2, 3)[..., None]
    o = o.reshape(b, lp, hq, dh)[:, :L].astype(q.dtype)
    m = m.transpose(0, 1, 4, 2, 3).reshape(b, lp, hq)[:, :L]
    s = s.transpose(0, 1, 4, 2, 3).reshape(b, lp, hq)[:, :L]
    return o, m, s


def _linear_combine(c1, c2):
    a1, b1 = c1
    a2, b2 = c2
    return a1 * a2, a2 * b1 + b2


def rg_lru_mixer(xa, gate, conv_w, conv_b, wa, ba, wx, bx, lam):
    b, s, c = xa.shape
    xp = jnp.pad(xa, ((0, 0), (CONV_LEFT, CONV_WIDTH - 1 - CONV_LEFT), (0, 0)))
    xc = conv_b + sum(conv_w[j] * xp[:, j:j + s] for j in range(CONV_WIDTH))
    xc = xc.astype(jnp.float32)
    xblk = xc.reshape(b, s, LRU_BLOCKS, c // LRU_BLOCKS)
    h_total = jnp.zeros_like(xc)
    for direction in range(2):
        r = jax.nn.sigmoid(jnp.einsum('bsnd,nde->bsne', xblk, wa[direction]).reshape(b, s, c) + ba[direction])
        i = jax.nn.sigmoid(jnp.einsum('bsnd,nde->bsne', xblk, wx[direction]).reshape(b, s, c) + bx[direction])
        log_a = -LRU_C * r * jax.nn.softplus(-lam[direction].astype(jnp.float32))
        a = jnp.exp(log_a)
        u = jnp.sqrt(-jnp.expm1(2.0 * log_a)) * (i * xc)
        _, h = lax.associative_scan(_linear_combine, (a, u), axis=1, reverse=(direction == 1))
        h_total = h_total + h
    return (h_total * jax.nn.gelu(gate.astype(jnp.float32))).astype(xa.dtype)


def dilated_attention(q, k, v):
    b, s, nh, dh = q.shape
    slopes = alibi_slopes(nh)
    outs, ms, dens = [], [], []
    for window, d in DIL_PATTERNS:
        n = s // d

        def strided(t):
            return t.reshape(b, n, d, nh, dh).transpose(0, 2, 1, 3, 4).reshape(b * d, n, nh, dh)

        o, m, den = banded_attention(strided(q), strided(k), strided(v), window // (2 * d), d, slopes)
        outs.append(o.reshape(b, d, n, nh, dh).transpose(0, 2, 1, 3, 4).reshape(b, s, nh, dh))
        ms.append(m.reshape(b, d, n, nh).transpose(0, 2, 1, 3).reshape(b, s, nh))
        dens.append(den.reshape(b, d, n, nh).transpose(0, 2, 1, 3).reshape(b, s, nh))
    o = jnp.stack(outs).astype(jnp.float32)
    m = jnp.stack(ms)
    den = jnp.stack(dens)
    wgt = den * jnp.exp(m - jnp.max(m, axis=0))
    return (jnp.sum(wgt[..., None] * o, axis=0) / jnp.sum(wgt, axis=0)[..., None]).astype(q.dtype)


def windowed_gqa_sink(q, k, v, sink):
    o, m, den = banded_attention(q, k, v, SWA_WINDOW, 1, alibi_slopes(q.shape[2]))
    factor = jax.nn.sigmoid(m + jnp.log(den) - sink.astype(jnp.float32))
    return (o.astype(jnp.float32) * factor[..., None]).astype(q.dtype)


def parallel_mixer(h, w_in, conv_w, conv_b, lru_wa, lru_ba, lru_wx, lru_bx, lru_lam, swa_sink, group_norm, w_out):
    b, s, _ = h.shape
    proj = jnp.einsum('bsd,de->bse', h, w_in)
    xa, gate, qb, kb, vb, qc, kc, vc = jnp.split(proj, IN_SPLITS, axis=-1)
    ya = rg_lru_mixer(xa, gate, conv_w, conv_b, lru_wa, lru_ba, lru_wx, lru_bx, lru_lam)
    yb = dilated_attention(qb.reshape(b, s, DIL_HEADS, HEAD_DIM), kb.reshape(b, s, DIL_HEADS, HEAD_DIM),
                           vb.reshape(b, s, DIL_HEADS, HEAD_DIM)).reshape(b, s, DIL_WIDTH)
    yc = windowed_gqa_sink(qc.reshape(b, s, SWA_HEADS, HEAD_DIM), kc.reshape(b, s, SWA_KV_HEADS, HEAD_DIM),
                           vc.reshape(b, s, SWA_KV_HEADS, HEAD_DIM), swa_sink).reshape(b, s, SWA_WIDTH)
    g_a, g_b, g_c = jnp.split(group_norm, GROUP_SPLITS)
    y = jnp.concatenate([rms_norm(ya, g_a), rms_norm(yb, g_b), rms_norm(yc, g_c)], axis=-1)
    return jnp.einsum('bse,ed->bsd', y, w_out)


def memory_cross_attention(h, mem_n, w_mq, w_mk, w_mv, w_mo):
    b, s, _ = h.shape
    q = jnp.einsum('bsd,de->bse', h, w_mq).reshape(b, s, MEM_HEADS, HEAD_DIM)
    k = jnp.einsum('bmd,de->bme', mem_n, w_mk).reshape(b, -1, MEM_HEADS, HEAD_DIM)
    v = jnp.einsum('bmd,de->bme', mem_n, w_mv).reshape(b, -1, MEM_HEADS, HEAD_DIM)
    scores = jnp.einsum('bshd,bmhd->bhsm', q, k, preferred_element_type=jnp.float32) * (HEAD_DIM ** -0.5)
    p = jax.nn.softmax(scores, axis=-1)
    o = jnp.einsum('bhsm,bmhd->bshd', p.astype(v.dtype), v).reshape(b, s, MEM_WIDTH)
    return jnp.einsum('bse,ed->bsd', o, w_mo)


def squared_relu_mlp(h, w_ff1, w_ff2):
    u = jnp.square(jax.nn.relu(jnp.einsum('bsd,df->bsf', h, w_ff1)))
    return jnp.einsum('bsf,fd->bsd', u, w_ff2)


def trunk(x, mem, weights):
    (mix_norm_pre, mix_norm_post, w_in, conv_w, conv_b, lru_wa, lru_ba, lru_wx, lru_bx, lru_lam,
     swa_sink, group_norm, w_out, mem_norm_pre, mem_norm_post, mem_kv_norm, w_mq, w_mk, w_mv, w_mo,
     ffn_norm_pre, ffn_norm_post, w_ff1, w_ff2) = weights
    for l in range(DEPTH):
        y = parallel_mixer(rms_norm(x, mix_norm_pre[l]), w_in[l], conv_w[l], conv_b[l], lru_wa[l], lru_ba[l],
                           lru_wx[l], lru_bx[l], lru_lam[l], swa_sink[l], group_norm[l], w_out[l])
        x = x + rms_norm(y, mix_norm_post[l])
        y = memory_cross_attention(rms_norm(x, mem_norm_pre[l]), rms_norm(mem, mem_kv_norm[l]),
                                   w_mq[l], w_mk[l], w_mv[l], w_mo[l])
        x = x + rms_norm(y, mem_norm_post[l])
        y = squared_relu_mlp(rms_norm(x, ffn_norm_pre[l]), w_ff1[l], w_ff2[l])
        x = x + rms_norm(y, ffn_norm_post[l])
    return x


def setup_inputs(seed: int = 0) -> dict:
    key = jax.random.key(seed)
    ks = iter(jax.random.split(key, 40))

    def nrm(shape, fan_in):
        return jax.random.normal(next(ks), shape, jnp.float32) * (fan_in ** -0.5)

    def gain(shape):
        return 1.0 + 0.05 * jax.random.normal(next(ks), shape, jnp.float32)

    def small(shape, scale=0.01):
        return scale * jax.random.normal(next(ks), shape, jnp.float32)

    blk = LRU_WIDTH // LRU_BLOCKS
    x_prompt = jax.random.normal(next(ks), (BATCH, SEQ, D_MODEL), jnp.float32)
    x_sample = jax.random.normal(next(ks), (DEC_BATCH, DEC_SEQ, D_MODEL), jnp.float32)
    mem_prompt = jax.random.normal(next(ks), (BATCH, N_MEM, D_MODEL), jnp.float32)
    mem_sample = jax.random.normal(next(ks), (DEC_BATCH, N_MEM, D_MODEL), jnp.float32)
    a0 = jax.random.uniform(next(ks), (DEPTH, 2, LRU_WIDTH), jnp.float32, 0.9, 0.999)
    lru_lam = jnp.log(a0) - jnp.log1p(-a0)
    return {
        'x_prompt': x_prompt,
        'x_sample': x_sample,
        'mem_prompt': mem_prompt,
        'mem_sample': mem_sample,
        'mix_norm_pre': gain((DEPTH, D_MODEL)),
        'mix_norm_post': gain((DEPTH, D_MODEL)),
        'w_in': nrm((DEPTH, D_MODEL, IN_WIDTH), D_MODEL),
        'conv_w': nrm((DEPTH, CONV_WIDTH, LRU_WIDTH), CONV_WIDTH),
        'conv_b': small((DEPTH, LRU_WIDTH)),
        'lru_wa': nrm((DEPTH, 2, LRU_BLOCKS, blk, blk), blk),
        'lru_ba': small((DEPTH, 2, LRU_WIDTH)),
        'lru_wx': nrm((DEPTH, 2, LRU_BLOCKS, blk, blk), blk),
        'lru_bx': small((DEPTH, 2, LRU_WIDTH)),
        'lru_lam': lru_lam,
        'swa_sink': jax.random.normal(next(ks), (DEPTH, SWA_HEADS), jnp.float32),
        'group_norm': gain((DEPTH, MIX_WIDTH)),
        'w_out': nrm((DEPTH, MIX_WIDTH, D_MODEL), MIX_WIDTH),
        'mem_norm_pre': gain((DEPTH, D_MODEL)),
        'mem_norm_post': gain((DEPTH, D_MODEL)),
        'mem_kv_norm': gain((DEPTH, D_MODEL)),
        'w_mq': nrm((DEPTH, D_MODEL, MEM_WIDTH), D_MODEL),
        'w_mk': nrm((DEPTH, D_MODEL, MEM_WIDTH), D_MODEL),
        'w_mv': nrm((DEPTH, D_MODEL, MEM_WIDTH), D_MODEL),
        'w_mo': nrm((DEPTH, MEM_WIDTH, D_MODEL), MEM_WIDTH),
        'ffn_norm_pre': gain((DEPTH, D_MODEL)),
        'ffn_norm_post': gain((DEPTH, D_MODEL)),
        'w_ff1': nrm((DEPTH, D_MODEL, D_FF), D_MODEL),
        'w_ff2': nrm((DEPTH, D_FF, D_MODEL), D_FF),
    }


def reference(x_prompt, x_sample, mem_prompt, mem_sample, mix_norm_pre, mix_norm_post, w_in, conv_w, conv_b,
              lru_wa, lru_ba, lru_wx, lru_bx, lru_lam, swa_sink, group_norm, w_out, mem_norm_pre, mem_norm_post,
              mem_kv_norm, w_mq, w_mk, w_mv, w_mo, ffn_norm_pre, ffn_norm_post, w_ff1, w_ff2):
    weights = (mix_norm_pre, mix_norm_post, w_in, conv_w, conv_b, lru_wa, lru_ba, lru_wx, lru_bx, lru_lam,
               swa_sink, group_norm, w_out, mem_norm_pre, mem_norm_post, mem_kv_norm, w_mq, w_mk, w_mv, w_mo,
               ffn_norm_pre, ffn_norm_post, w_ff1, w_ff2)
    y_prompt = trunk(x_prompt, mem_prompt, weights)
    y_sample = trunk(x_sample, mem_sample, weights)
    return (y_prompt, y_sample)
```

```cpp
#include <hip/hip_runtime.h>
#include <cstdio>
#include <cstdint>
namespace pg8 {
#define PG8_LAS __attribute__((address_space(3)))
typedef unsigned short bf16_t;
typedef short bf16x8 __attribute__((ext_vector_type(8)));
typedef float f32x4 __attribute__((ext_vector_type(4)));
typedef unsigned u32x4 __attribute__((ext_vector_type(4)));
constexpr int BM = 256, BK = 64, HALF = 128, HTB = HALF * BK * 2  , STAGE_BYTES = 8 * HTB, NXCD = 8, WGM = 8;

__host__ __device__ __forceinline__ int lds_byte(int r, int c) { const int st = (r >> 4) * 2 + (c >> 5), rr = r & 15, cc = c & 31, ob = rr * 64 + cc * 2; return st * 1024 + (ob ^ (((ob >> 9) & 1) << 5)); }
__host__ __device__ __forceinline__ void stage_rc(int b, int& R, int& C) { const int st = b / 1024, sb = b % 1024, swz = sb ^ (((sb >> 9) & 1) << 5); R = (st >> 1) * 16 + swz / 64; C = (st & 1) * 32 + (swz % 64) / 2; }
__host__ __device__ __forceinline__ int perm32(int rho) { const int n = rho >> 4, i = rho & 15; return 8 * (i >> 2) + 4 * n + (i & 3); }

struct Unit { int pm, pn; };
struct Gemm { const bf16_t* A; const bf16_t* Bt; int M, N, K; };

struct StaticOrder {
    int nM, nN, nwg, G, c;
    __host__ __device__ void init(int M, int N, int G_, int c_) { nM = M / BM; nN = N / BM; nwg = nM * nN; G = G_; c = c_; }
    __host__ __device__ bool next(int i, Unit& u) const {
        const long L = (long)i * G + c; if (L >= nwg) return false;
        int wgid = (int)L; { const int q = nwg / NXCD, r = nwg % NXCD, xcd = wgid % NXCD, off = wgid / NXCD; wgid = (xcd < r ? xcd * (q + 1) : r * (q + 1) + (xcd - r) * q) + off; }
        const int nig = WGM * nN, gid = wgid / nig, fm = gid * WGM, gsz = (nM - fm) < WGM ? (nM - fm) : WGM;
        u.pm = fm + ((wgid % nig) % gsz); u.pn = (wgid % nig) / gsz; return true;
    }
    __device__ __forceinline__ void a_ready(const Unit&) const {}
    __device__ __forceinline__ void done(const Unit&) const {}
};

__device__ __forceinline__ unsigned cvt_pk_bf16(float lo, float hi) { unsigned r; asm volatile("v_cvt_pk_bf16_f32 %0, %1, %2" : "=v"(r) : "v"(lo), "v"(hi)); return r; }
template <int ACT  > struct EpiBf16 {
    static constexpr bool PERM = true, AFTER_DRAIN = false;
    bf16_t* O; int ldc; const float* bias; const float* rs;
    __device__ __forceinline__ void fused(f32x4 (&)[2][2][4][2], const Unit&, int, int, int, int, PG8_LAS unsigned char*, int, int) const {}
    __device__ __forceinline__ void operator()(const f32x4 (&acc)[2][2][4][2], const Unit& u, int wr, int wc, int fr, int fq) const {
        const int row0 = u.pm * BM + wr * 64 + fr; const int colt = u.pn * BM; bf16_t* base = O;
        const int col0 = colt + wc * 32 + 8 * fq;
        f32x4 bv[2][2];
#pragma unroll
        for (int bj = 0; bj < 2; ++bj)
#pragma unroll
            for (int n = 0; n < 2; ++n) bv[bj][n] = bias ? *(const f32x4*)(bias + col0 + bj * HALF + 4 * n) : (f32x4){0.f, 0.f, 0.f, 0.f};
#pragma unroll
        for (int ai = 0; ai < 2; ++ai)
#pragma unroll
            for (int m = 0; m < 4; ++m) { bf16_t* rowp = base + (size_t)(row0 + ai * HALF + m * 16) * ldc + col0; const float sc = rs ? rs[row0 + ai * HALF + m * 16] : 1.f;
#pragma unroll
                for (int bj = 0; bj < 2; ++bj) { f32x4 v0 = (acc[ai][bj][m][0] + bv[bj][0]) * sc, v1 = (acc[ai][bj][m][1] + bv[bj][1]) * sc;
                    if (ACT == 1) {
#pragma unroll
                        for (int j = 0; j < 4; ++j) { const float a = fmaxf(v0[j], 0.f), b = fmaxf(v1[j], 0.f); v0[j] = a * a; v1[j] = b * b; } }
                    u32x4 w; w.x = cvt_pk_bf16(v0[0], v0[1]); w.y = cvt_pk_bf16(v0[2], v0[3]); w.z = cvt_pk_bf16(v1[0], v1[1]); w.w = cvt_pk_bf16(v1[2], v1[3]);
                    *(u32x4*)(rowp + bj * HALF) = w; } }
    }
};

template <class Epi, class Sched, bool ALIGN_EPI = false, bool SP2 = false, int KS = 0>
__device__ __forceinline__ void gemm_phase(PG8_LAS unsigned char* lds, const Gemm g, const Sched& S, const Epi& E, const int tid_in) {
    int tid_ = tid_in; asm volatile("" : "+v"(tid_));
    const int tid = tid_, wid = __builtin_amdgcn_readfirstlane(tid >> 6), lane = tid & 63, wr = wid >> 2, wc = wid & 3, fr = lane & 15, fq = lane >> 4;
    const int K = g.K, KB = KS ? KS : K; int nt = KB / BK; if (KS) asm volatile("" : "+s"(nt));
    unsigned voffA[2], voffB[2];
#pragma unroll
    for (int i = 0; i < 2; ++i) { int R, C; stage_rc(tid * 16 + i * 8192, R, C); const int Rb = Epi::PERM ? ((R & ~31) + perm32(R & 31)) : R;
        voffA[i] = (unsigned)(R * K + C) * 2u; voffB[i] = (unsigned)(Rb * KB + C) * 2u; }
    const size_t kstep = (size_t)(BK * 2);
    const size_t hstep = (size_t)HALF * K * 2;
    const size_t tstep = 2 * hstep;
    const size_t hstepB = (size_t)HALF * KB * 2, tstepB = 2 * hstepB;
    const unsigned ldsw = (unsigned)wid * 1024u;
    const int aoff = lds_byte(wr * 64 + fr, fq * 8), boff = lds_byte(wc * 32 + fr, fq * 8);
#define PG8_SA(b, h) (((b) * 2 + (h)) * HTB)
#define PG8_SB(b, h) ((4 + (b) * 2 + (h)) * HTB)
#define PG8_STAGE(bufoff, gbase, voff) do { _Pragma("unroll") for (int _i = 0; _i < 2; ++_i) \
        __builtin_amdgcn_global_load_lds((const unsigned*)((const char*)(gbase) + (voff)[_i]), (PG8_LAS unsigned*)(lds + (bufoff) + ldsw + _i * 8192), 16, 0, 0); } while (0)
#define PG8_LDA(dst, b, h) do { _Pragma("unroll") for (int m = 0; m < 4; ++m) _Pragma("unroll") for (int k = 0; k < 2; ++k) dst[m][k] = *(const PG8_LAS bf16x8*)(lds + PG8_SA(b, h) + aoff + m * 2048 + k * 1024); } while (0)
#define PG8_LDB(dst, b, h) do { _Pragma("unroll") for (int n = 0; n < 2; ++n) _Pragma("unroll") for (int k = 0; k < 2; ++k) dst[n][k] = *(const PG8_LAS bf16x8*)(lds + PG8_SB(b, h) + boff + n * 2048 + k * 1024); } while (0)
#define PG8_MMA(ai, bj, At, Bt) do { __builtin_amdgcn_s_setprio(1); _Pragma("unroll") for (int m = 0; m < 4; ++m) _Pragma("unroll") for (int n = 0; n < 2; ++n) _Pragma("unroll") for (int k = 0; k < 2; ++k) \
        acc[ai][bj][m][n] = __builtin_amdgcn_mfma_f32_16x16x32_bf16(Bt[n][k], At[m][k], acc[ai][bj][m][n], 0, 0, 0); __builtin_amdgcn_s_setprio(0); } while (0)
#define PG8_WAIT_V(n) asm volatile("s_waitcnt vmcnt(" #n ")" ::: "memory")
#define PG8_WAIT_L(n) asm volatile("s_waitcnt lgkmcnt(" #n ")" ::: "memory")
#define PG8_BAR __builtin_amdgcn_s_barrier()
#define PG8_SCHED __builtin_amdgcn_sched_barrier(0)
    Unit cur, nxt; int ui = 0;
    if (!S.next(0, cur)) return;
    f32x4 acc[2][2][4][2];
#pragma unroll
    for (int a = 0; a < 2; ++a)
#pragma unroll
        for (int b = 0; b < 2; ++b)
#pragma unroll
            for (int m = 0; m < 4; ++m)
#pragma unroll
                for (int n = 0; n < 2; ++n) acc[a][b][m][n] = (f32x4){0.f, 0.f, 0.f, 0.f};
    bf16x8 At[4][2], B0[2][2], B1[2][2];
    const char* cA = (const char*)g.A + (size_t)cur.pm * tstep + (KS ? (size_t)(cur.pn >> 1) * (KS * 2) : 0); const char* cB = (const char*)g.Bt + (size_t)cur.pn * tstepB;
    S.a_ready(cur);
    if constexpr (SP2) {
        PG8_STAGE(PG8_SB(0, 0), cB, voffB); PG8_STAGE(PG8_SB(0, 1), cB + hstepB, voffB); PG8_STAGE(PG8_SA(0, 0), cA, voffA); PG8_STAGE(PG8_SA(0, 1), cA + hstep, voffA);
        if (wr == 1) PG8_BAR;
        PG8_WAIT_V(2); PG8_BAR;
        PG8_STAGE(PG8_SB(1, 0), cB + kstep, voffB); PG8_STAGE(PG8_SA(1, 0), cA + kstep, voffA); PG8_STAGE(PG8_SB(1, 1), cB + hstepB + kstep, voffB);
        PG8_WAIT_V(6); PG8_BAR;
    } else {
        PG8_STAGE(PG8_SB(0, 0), cB, voffB); PG8_STAGE(PG8_SA(0, 0), cA, voffA); PG8_STAGE(PG8_SB(0, 1), cB + hstepB, voffB); PG8_STAGE(PG8_SA(0, 1), cA + hstep, voffA);
        if (wr == 1) PG8_BAR;
        PG8_WAIT_V(4); PG8_BAR;
        PG8_STAGE(PG8_SB(1, 0), cB + kstep, voffB); PG8_STAGE(PG8_SA(1, 0), cA + kstep, voffA); PG8_STAGE(PG8_SB(1, 1), cB + hstepB + kstep, voffB);
        PG8_WAIT_V(6); PG8_BAR;
    }
    for (;;) {
        const bool has_next = S.next(ui + 1, nxt);
        const char* nA = has_next ? (const char*)g.A + (size_t)nxt.pm * tstep + (KS ? (size_t)(nxt.pn >> 1) * (KS * 2) : 0) : cA; const char* nB = has_next ? (const char*)g.Bt + (size_t)nxt.pn * tstepB : cB;
        asm volatile(".p2align 6\n .rept 12\n s_nop 0\n .endr" ::: "memory");
        for (int t = 0; t < nt; t += 2) {
            const bool last = (t == nt - 2);
            const char* a1 = cA + (size_t)(t + 1) * kstep;
            const char* a2 = last ? nA : cA + (size_t)(t + 2) * kstep; const char* b2 = last ? nB : cB + (size_t)(t + 2) * kstep;
            const char* a3 = a2 + kstep; const char* b3 = b2 + kstep;
            if (last && has_next) S.a_ready(nxt);
            if constexpr (SP2) {
            PG8_LDB(B0, 0, 0); PG8_LDB(B1, 0, 1); PG8_SCHED; PG8_LDA(At, 0, 0); PG8_STAGE(PG8_SA(1, 1), a1 + hstep, voffA);
            PG8_WAIT_V(8); PG8_WAIT_L(0); PG8_BAR; PG8_MMA(0, 0, At, B0); PG8_MMA(0, 1, At, B1); PG8_BAR; PG8_SCHED;
            PG8_LDA(At, 0, 1); PG8_STAGE(PG8_SB(0, 0), b2, voffB); PG8_STAGE(PG8_SB(0, 1), b2 + hstepB, voffB); PG8_STAGE(PG8_SA(0, 0), a2, voffA);
            PG8_WAIT_V(8); PG8_WAIT_L(0); PG8_BAR; PG8_MMA(1, 0, At, B0); PG8_MMA(1, 1, At, B1); PG8_BAR; PG8_SCHED;
            PG8_LDB(B0, 1, 0); PG8_LDB(B1, 1, 1); PG8_SCHED; PG8_LDA(At, 1, 0); PG8_STAGE(PG8_SA(0, 1), a2 + hstep, voffA);
            PG8_WAIT_V(8); PG8_WAIT_L(0); PG8_BAR; PG8_MMA(0, 0, At, B0); PG8_MMA(0, 1, At, B1); PG8_BAR; PG8_SCHED;
            PG8_LDA(At, 1, 1); PG8_STAGE(PG8_SB(1, 0), b3, voffB); PG8_STAGE(PG8_SB(1, 1), b3 + hstepB, voffB); PG8_STAGE(PG8_SA(1, 0), a3, voffA);
            PG8_WAIT_V(8); PG8_WAIT_L(0); PG8_BAR; PG8_MMA(1, 0, At, B0); PG8_MMA(1, 1, At, B1); PG8_BAR; PG8_SCHED;
            } else {
            PG8_LDB(B0, 0, 0); PG8_SCHED; PG8_LDA(At, 0, 0); PG8_STAGE(PG8_SA(1, 1), a1 + hstep, voffA);
            PG8_WAIT_L(8); PG8_BAR; PG8_WAIT_L(0); PG8_MMA(0, 0, At, B0); PG8_BAR; PG8_SCHED;
            PG8_LDB(B1, 0, 1); PG8_STAGE(PG8_SB(0, 0), b2, voffB);
            PG8_BAR; PG8_WAIT_L(0); PG8_MMA(0, 1, At, B1); PG8_BAR;
            PG8_LDA(At, 0, 1); PG8_STAGE(PG8_SA(0, 0), a2, voffA);
            PG8_BAR; PG8_WAIT_L(0); PG8_MMA(1, 0, At, B0); PG8_BAR; PG8_SCHED;
            PG8_STAGE(PG8_SB(0, 1), b2 + hstepB, voffB);
            PG8_WAIT_V(6); PG8_BAR; PG8_MMA(1, 1, At, B1); PG8_BAR;
            PG8_LDB(B0, 1, 0); PG8_SCHED; PG8_LDA(At, 1, 0); PG8_STAGE(PG8_SA(0, 1), a2 + hstep, voffA);
            PG8_WAIT_L(8); PG8_BAR; PG8_WAIT_L(0); PG8_MMA(0, 0, At, B0); PG8_BAR; PG8_SCHED;
            PG8_LDB(B1, 1, 1); PG8_STAGE(PG8_SB(1, 0), b3, voffB);
            PG8_BAR; PG8_WAIT_L(0); PG8_MMA(0, 1, At, B1); PG8_BAR;
            PG8_LDA(At, 1, 1); PG8_STAGE(PG8_SA(1, 0), a3, voffA);
            PG8_BAR; PG8_WAIT_L(0); PG8_MMA(1, 0, At, B0); PG8_BAR; PG8_SCHED;
            PG8_STAGE(PG8_SB(1, 1), b3 + hstepB, voffB);
            PG8_WAIT_V(6); PG8_BAR; PG8_MMA(1, 1, At, B1); PG8_BAR;
            }
        }
        if constexpr (ALIGN_EPI) { if (wr == 0) PG8_BAR; }
        if constexpr (!Epi::AFTER_DRAIN) { E(acc, cur, wr, wc, fr, fq); S.done(cur); }
        if (!has_next) break;
#pragma unroll
        for (int a = 0; a < 2; ++a)
#pragma unroll
            for (int b = 0; b < 2; ++b)
#pragma unroll
                for (int m = 0; m < 4; ++m)
#pragma unroll
                    for (int n = 0; n < 2; ++n) acc[a][b][m][n] = (f32x4){0.f, 0.f, 0.f, 0.f};
        cur = nxt; cA = nA; cB = nB; ++ui;
        if constexpr (ALIGN_EPI) { if (wr == 1) PG8_BAR; }
    }
    PG8_WAIT_V(0);
    if constexpr (!ALIGN_EPI) { if (wr == 0) PG8_BAR; }
    PG8_BAR;
    if constexpr (Epi::AFTER_DRAIN) { E.fused(acc, cur, wr, wc, fr, fq, lds, wid, lane); S.done(cur); }
#undef PG8_SA
#undef PG8_SB
#undef PG8_STAGE
#undef PG8_LDA
#undef PG8_LDB
#undef PG8_MMA
#undef PG8_WAIT_V
#undef PG8_WAIT_L
#undef PG8_BAR
#undef PG8_SCHED
}
}

constexpr int NWAVES = 8;
#ifndef MK_PER_PHASE
#define MK_PER_PHASE 0
#endif
constexpr int D = 2048, DEPTH = 4, SEQ_P = 4096, NB_P = 8, SEQ_S = 16384;
constexpr int MP = NB_P * SEQ_P;
constexpr int M = MP + SEQ_S;
constexpr int HD = 128, LRU_W = 512, IN_W = 4608;
constexpr float QSCALE2 = 0.08838834764831845f * 1.4426950408889634f;
constexpr int C_XA = 0, C_GATE = 512, C_QB = 1024, C_KB = 1792, C_VB = 2560, C_QC = 3328, C_KC = 4096, C_VC = 4352;
constexpr int PA_W = 1024, NHB = 28;
constexpr int NMEM = 256, MEM_W = 512, NSEQ = 9, MMEM = NSEQ * NMEM;
constexpr int DFF = 8192, FCH = 8192, NFCH = 6;
constexpr float EPS = 1e-6f;
constexpr int LCH = 32, NCHK = M / LCH;
enum { P_CONV = 0, P_PROJ, P_XC, P_GATES, P_AGG, P_CARRY, P_LRU, P_ATT, P_COMB, P_WOUT, P_ROW1, P_MQ, P_XATT, P_MO, P_ROW2, P_FF0, P_FF1, P_ROW3 = P_FF0 + 2 * 6, NP };
constexpr int NPHASES = NP * DEPTH;

constexpr size_t MiB = 1u << 20;
constexpr size_t WS_CTL = 0, CTL_ZERO_BYTES = 1 * MiB;
constexpr size_t WS_WIN = 2 * MiB, WS_WOUT = 20 * MiB, WS_WMQ = 28 * MiB, WS_WMKV = 30 * MiB, WS_WMO = 34 * MiB, WS_WG = 36 * MiB, WS_W1 = 38 * MiB, WS_W2 = 70 * MiB;
constexpr size_t WS_MEMN = 102 * MiB, WS_MEMKV = 111 * MiB, WS_AGG = 116 * MiB, WS_GBIAS = 122 * MiB;
constexpr size_t WS_XH = 124 * MiB, WS_XL = 316 * MiB, WS_YBUF = 508 * MiB, WS_PROJ = 700 * MiB, WS_AGG2 = 1132 * MiB, WS_CAR = 1148 * MiB, WS_RSTD = 1156 * MiB, WS_END = 1157 * MiB;
constexpr size_t OUT_XC = 0, OUT_YMIX = 48 * MiB;
static_assert(OUT_YMIX + (size_t)M * D * 2 <= (size_t)M * D * 4, "d_out scratch map");
constexpr size_t WS_U = WS_PROJ, WS_Q = WS_PROJ + 256 * MiB, WS_O = WS_PROJ + 304 * MiB;
static_assert(WS_PROJ + (size_t)M * IN_W * 2 <= WS_AGG2 && WS_O + (size_t)M * MEM_W * 2 <= WS_AGG2 && WS_U + (size_t)FCH * DFF * 2 <= WS_AGG2, "ws map");
constexpr int CW_BAR = 4096;

constexpr int RING_OFF = 0, RING_BYTES = 131072;
constexpr int LDSCTL_OFF = 8 * 16640, MISC_OFF = LDSCTL_OFF + 320;
constexpr int LDS_BYTES = 147456;

#define GAS __attribute__((address_space(1)))
#define LAS __attribute__((address_space(3)))
typedef unsigned short bf16;
typedef unsigned v4u __attribute__((ext_vector_type(4)));
typedef unsigned v2u __attribute__((ext_vector_type(2)));
typedef float f32x4 __attribute__((ext_vector_type(4)));
typedef GAS unsigned gu32;
typedef unsigned u32x4_t __attribute__((ext_vector_type(4)));
#define RLX_AGENT __ATOMIC_RELAXED, __HIP_MEMORY_SCOPE_AGENT
#define LDS_WAIT() asm volatile("s_waitcnt lgkmcnt(0)" ::: "memory")
#define VM_WAIT() asm volatile("s_waitcnt vmcnt(0)" ::: "memory")
__device__ __forceinline__ unsigned f2bf(float f) { unsigned u = __builtin_bit_cast(unsigned, f); return (u + 0x7fffu + ((u >> 16) & 1u)) >> 16; }
__device__ __forceinline__ unsigned pk2(float lo, float hi) { return f2bf(lo) | (f2bf(hi) << 16); }
typedef float f32x2_t __attribute__((ext_vector_type(2)));
typedef __bf16 bf16x2_t __attribute__((ext_vector_type(2)));
__device__ __forceinline__ unsigned cvtpk_s(float lo, float hi) { f32x2_t v = {lo, hi}; bf16x2_t b = __builtin_convertvector(v, bf16x2_t); return __builtin_bit_cast(unsigned, b); }
__device__ __forceinline__ float bflo(unsigned u) { return __uint_as_float(u << 16); }
__device__ __forceinline__ float bfhi(unsigned u) { return __uint_as_float(u & 0xffff0000u); }
__device__ __forceinline__ float bf1(bf16 b) { return __uint_as_float(((unsigned)b) << 16); }

#define XB_TMO      128
#define XB_XCNT(j)  (256  + 64 * (j))
#define XB_XSUB(j)  (1280 + 64 * (j))
#define XB_XGEN(j)  (2304 + 64 * (j))
#define XB_TOP      3328
#define XB_TOPGEN   3392
#define XCD_BAR_WORDS 3456
#define XB_SPIN_CAP (1u << 18)

__device__ __forceinline__ unsigned xb_ld(unsigned* p)              { return __hip_atomic_load(p, __ATOMIC_RELAXED, __HIP_MEMORY_SCOPE_AGENT); }
__device__ __forceinline__ unsigned xb_add(unsigned* p, unsigned v) { return __hip_atomic_fetch_add(p, v, __ATOMIC_RELAXED, __HIP_MEMORY_SCOPE_AGENT); }
__device__ __forceinline__ unsigned xb_xcc_id() { return (unsigned)__builtin_amdgcn_s_getreg((3 << 11) | 20) & 0xFu; }
#define XB_SPIN(cond, bar) do { unsigned _sp = 0; while (cond) { __builtin_amdgcn_s_sleep(1); \
    if ((++_sp & 255u) == 0u) { if (xb_ld(&(bar)[XB_TMO])) break; if (_sp > XB_SPIN_CAP) { atomicAdd(&(bar)[XB_TMO], 1u); break; } } } } while (0)

struct XcdBarrier {
    unsigned* bar; unsigned x;
    volatile LAS unsigned* st;
};

__device__ __forceinline__ XcdBarrier xcd_barrier_post(unsigned* bar, volatile LAS unsigned* st) {
    XcdBarrier b; b.bar = bar; b.x = xb_xcc_id(); b.st = st;
    if (threadIdx.x == 0) (void)xb_add(&bar[XB_XCNT(b.x)], 1u);
    return b;
}
__device__ __forceinline__ void xcd_barrier_complete(unsigned* bar, unsigned x, unsigned& nloc, unsigned& nx) {
    const unsigned G = gridDim.x * gridDim.y * gridDim.z;
    unsigned sum, cnt, mine, sp = 0u;
    for (;;) {
        sum = 0u; cnt = 0u; mine = 0u;
#pragma unroll
        for (unsigned j = 0; j < 16; ++j) { const unsigned c = xb_ld(&bar[XB_XCNT(j)]); sum += c; cnt += (c > 0u) ? 1u : 0u; mine = (j == x) ? c : mine; }
        if (sum == G) break;
        __builtin_amdgcn_s_sleep(1);
        if ((++sp & 255u) == 0u) { if (xb_ld(&bar[XB_TMO])) break; if (sp > XB_SPIN_CAP) { atomicAdd(&bar[XB_TMO], 1u); break; } }
    }
    nloc = mine > 0u ? mine : 1u; nx = cnt > 0u ? cnt : 1u;
}

__device__ __forceinline__ void xcd_barrier(const XcdBarrier& b) {
    asm volatile("s_waitcnt vmcnt(0)" ::: "memory");
    __syncthreads();
    if (threadIdx.x == 0) {
        unsigned* bar = b.bar;
        __builtin_amdgcn_s_waitcnt(0);
        unsigned nloc = b.st[0], nx = b.st[1];
        if (nloc == 0u) { xcd_barrier_complete(bar, b.x, nloc, nx); b.st[0] = nloc; b.st[1] = nx; }
        const unsigned old = xb_add(&bar[XB_XSUB(b.x)], 1u);
        const unsigned gen = old / nloc;
        if (old + 1u == (gen + 1u) * nloc) {
            __builtin_amdgcn_fence(__ATOMIC_RELEASE, "agent");
            asm volatile("s_waitcnt vmcnt(0)" ::: "memory");
            const unsigned og = xb_add(&bar[XB_TOP], 1u);
            const unsigned tg = og / nx;
            if (og + 1u == (tg + 1u) * nx) xb_add(&bar[XB_TOPGEN], 1u);
            else XB_SPIN(xb_ld(&bar[XB_TOPGEN]) == tg, bar);
            __builtin_amdgcn_fence(__ATOMIC_ACQUIRE, "agent");
            xb_add(&bar[XB_XGEN(b.x)], 1u);
            asm volatile("s_waitcnt vmcnt(0)" ::: "memory");
        } else {
            XB_SPIN(xb_ld(&bar[XB_XGEN(b.x)]) == gen, bar);
            __builtin_amdgcn_fence(__ATOMIC_ACQUIRE, "agent");
            asm volatile("s_waitcnt vmcnt(0)" ::: "memory");
        }
    }
    __syncthreads();
}


__device__ __forceinline__ float wave_sum_fast(float v) {
#define DPPF(x, ctrl) __builtin_bit_cast(float, __builtin_amdgcn_update_dpp(0, __builtin_bit_cast(int, x), ctrl, 0xf, 0xf, false))
    v += DPPF(v, 0x128); v += DPPF(v, 0x124); v += DPPF(v, 0x122); v += DPPF(v, 0x121);
#undef DPPF
    const int iv = __builtin_bit_cast(int, v);
    return (__builtin_bit_cast(float, __builtin_amdgcn_readlane(iv, 0)) + __builtin_bit_cast(float, __builtin_amdgcn_readlane(iv, 16))) +
           (__builtin_bit_cast(float, __builtin_amdgcn_readlane(iv, 32)) + __builtin_bit_cast(float, __builtin_amdgcn_readlane(iv, 48)));
}
__device__ __forceinline__ float fsig(float x) { return __builtin_amdgcn_rcpf(1.f + __builtin_amdgcn_exp2f(-1.4426950408889634f * x)); }
__device__ __forceinline__ float fgelu(float x) { return x * fsig(1.5957691216057308f * (x + 0.044715f * x * x * x)); }
__device__ __forceinline__ void lru_au(float gr, float gi, float xv, float sp2, float& a, float& u) {
    const float r = fsig(gr), ig = fsig(gi); a = __builtin_amdgcn_exp2f(-r * sp2); u = __builtin_amdgcn_sqrtf(fmaxf(1.f - a * a, 0.f)) * (ig * xv); }
__device__ __forceinline__ void lru_lu(float gr, float gi, float xv, float sp2, float& la, float& u) {
    const float r = fsig(gr), ig = fsig(gi); la = -r * sp2; const float a = __builtin_amdgcn_exp2f(la); u = __builtin_amdgcn_sqrtf(fmaxf(1.f - a * a, 0.f)) * (ig * xv); }
struct EpiProj {
    static constexpr bool PERM = true, AFTER_DRAIN = false; static constexpr int NSTORES = 16;
    bf16* PA; bf16* HB;
    __device__ __forceinline__ void operator()(const pg8::f32x4 (&acc)[2][2][4][2], const pg8::Unit& u, int wr, int wc, int fr, int fq) const {
        const int row0 = u.pm * 256 + wr * 64 + fr, colt = u.pn * 256, cw = wc * 32 + 8 * fq;
#pragma unroll
        for (int bj = 0; bj < 2; ++bj) {
            const int cb = colt + bj * 128;
            bf16* base; size_t ld;
            if (cb < PA_W) { base = PA + cb + cw; ld = PA_W; } else { base = HB + (size_t)((cb - PA_W) >> 7) * M * HD + cw; ld = HD; }
#pragma unroll
            for (int ai = 0; ai < 2; ++ai)
#pragma unroll
                for (int m = 0; m < 4; ++m) { const pg8::f32x4 v0 = acc[ai][bj][m][0], v1 = acc[ai][bj][m][1];
                    v4u w; w.x = cvtpk_s(v0[0], v0[1]); w.y = cvtpk_s(v0[2], v0[3]); w.z = cvtpk_s(v1[0], v1[1]); w.w = cvtpk_s(v1[2], v1[3]);
                    *(v4u*)(base + (size_t)(row0 + ai * 128 + m * 16) * ld) = w; }
        }
    }
};
struct EpiLU {
    static constexpr bool PERM = true, AFTER_DRAIN = false; static constexpr int NSTORES = 16;
    bf16* LU; const bf16* XC; const float* bias; const float* lam;
    __device__ __forceinline__ void operator()(const pg8::f32x4 (&acc)[2][2][4][2], const pg8::Unit& u, int wr, int wc, int fr, int fq) const {
        const int row0 = u.pm * 256 + wr * 64 + fr, col0 = u.pn * 256 + wc * 32 + 8 * fq;
#pragma unroll
        for (int bj = 0; bj < 2; ++bj) {
            const int col = col0 + bj * 128, c0 = col >> 2;
            const f32x4 b0 = *(const f32x4*)(bias + col), b1 = *(const f32x4*)(bias + col + 4);
            float sp[2][2];
#pragma unroll
            for (int dr = 0; dr < 2; ++dr)
#pragma unroll
                for (int e = 0; e < 2; ++e) sp[dr][e] = 8.f * __builtin_amdgcn_logf(1.f + __builtin_amdgcn_exp2f(-1.4426950408889634f * lam[dr * 512 + c0 + e]));
#pragma unroll
            for (int ai = 0; ai < 2; ++ai)
#pragma unroll
                for (int m = 0; m < 4; ++m) { const size_t r = (size_t)(row0 + ai * 128 + m * 16);
                    const unsigned xw = *(const unsigned*)(XC + r * LRU_W + c0);
                    const f32x4 g0 = acc[ai][bj][m][0] + b0, g1 = acc[ai][bj][m][1] + b1;
                    float laf0, lab0, laf1, lab1, uf0, ub0, uf1, ub1;
                    lru_lu(g0.x, g0.y, bflo(xw), sp[0][0], laf0, uf0); lru_lu(g0.z, g0.w, bflo(xw), sp[1][0], lab0, ub0);
                    lru_lu(g1.x, g1.y, bfhi(xw), sp[0][1], laf1, uf1); lru_lu(g1.z, g1.w, bfhi(xw), sp[1][1], lab1, ub1);
                    v4u o; o.x = cvtpk_s(laf0, uf0); o.y = cvtpk_s(lab0, ub0); o.z = cvtpk_s(laf1, uf1); o.w = cvtpk_s(lab1, ub1);
                    *(v4u*)(LU + (r * LRU_W + c0) * 4) = o; }
        }
    }
};
__device__ __forceinline__ int seq_start_row(int m) { return m < MP ? (m & ~(SEQ_P - 1)) : MP; }
__device__ __forceinline__ int seq_end_row(int m) { return m < MP ? (m & ~(SEQ_P - 1)) + SEQ_P : M; }

__device__ __forceinline__ void transpose_item(const float* W, int K, int N, bf16* WT, int row_off, LAS float* scr, int item, int lane) {
    const int nblk = N / 32, kb = item / nblk, nb = item % nblk, k0 = 64 * kb, n0 = 32 * nb;
#pragma unroll 8
    for (int i = 0; i < 32; ++i) { const int kk = 2 * i + (lane >> 5); scr[kk * 33 + (lane & 31)] = W[(size_t)(k0 + kk) * N + n0 + (lane & 31)]; }
    LDS_WAIT(); asm volatile("" ::: "memory");
    const int c = lane & 7;
#pragma unroll
    for (int j = 0; j < 4; ++j) { const int n = (lane >> 3) + 8 * j; const LAS float* s = scr + (8 * c) * 33 + n;
        v4u o; o.x = pk2(s[0 * 33], s[1 * 33]); o.y = pk2(s[2 * 33], s[3 * 33]); o.z = pk2(s[4 * 33], s[5 * 33]); o.w = pk2(s[6 * 33], s[7 * 33]);
        *(GAS v4u*)(WT + (size_t)(row_off + n0 + n) * K + k0 + 8 * c) = o; }
    LDS_WAIT(); asm volatile("" ::: "memory");
}

struct TItem { const float* W; bf16* WT; int K, N, row_off, k0, n0; const float* gk; float cs; };
__device__ __forceinline__ void titem_load(const TItem& t, int lane, f32x4 (&v)[16]) {
    const float* p = t.W + (size_t)(t.k0 + (lane >> 4)) * t.N + t.n0 + 4 * (lane & 15);
#pragma unroll
    for (int i = 0; i < 16; ++i) v[i] = __builtin_nontemporal_load((const f32x4*)(p + (size_t)(4 * i) * t.N));
}
__device__ __forceinline__ void titem_store(const TItem& t, int lane, const f32x4 (&v)[16], LAS float* scr) {
    const int r4 = lane >> 4, c4 = lane & 15;
#pragma unroll
    for (int i = 0; i < 16; ++i) { LAS float* s = scr + (4 * c4) * 65 + 4 * i + r4; const float g = (t.gk ? t.gk[t.k0 + 4 * i + r4] : 1.f) * t.cs; s[0] = v[i].x * g; s[65] = v[i].y * g; s[130] = v[i].z * g; s[195] = v[i].w * g; }
    LDS_WAIT(); asm volatile("" ::: "memory");
    const int nn = lane >> 3, c = lane & 7;
#pragma unroll
    for (int j = 0; j < 8; ++j) { const int n = nn + 8 * j; const LAS float* s = scr + n * 65 + 8 * c;
        v4u o; o.x = cvtpk_s(s[0], s[1]); o.y = cvtpk_s(s[2], s[3]); o.z = cvtpk_s(s[4], s[5]); o.w = cvtpk_s(s[6], s[7]);
        *(v4u*)(t.WT + (size_t)(t.row_off + t.n0 + n) * t.K + t.k0 + 8 * c) = o; if (j & 1) asm volatile("" ::: "memory"); }
    LDS_WAIT(); asm volatile("" ::: "memory");
}
__device__ __forceinline__ void row_pass(const float* xin, const bf16* yrow, const float* gpost, float* xout, const float* gnext, bf16* hrow, int lane) {
    float x[32];
#pragma unroll
    for (int j = 0; j < 4; ++j) { const f32x4 a = *(const f32x4*)(xin + j * 512 + lane * 8), b = *(const f32x4*)(xin + j * 512 + lane * 8 + 4);
        x[8 * j + 0] = a.x; x[8 * j + 1] = a.y; x[8 * j + 2] = a.z; x[8 * j + 3] = a.w; x[8 * j + 4] = b.x; x[8 * j + 5] = b.y; x[8 * j + 6] = b.z; x[8 * j + 7] = b.w; }
    if (yrow) {
        float y[32]; float ss = 0.f;
#pragma unroll
        for (int j = 0; j < 4; ++j) { const v4u w = *(const v4u*)(yrow + j * 512 + lane * 8);
            y[8 * j + 0] = bflo(w.x); y[8 * j + 1] = bfhi(w.x); y[8 * j + 2] = bflo(w.y); y[8 * j + 3] = bfhi(w.y); y[8 * j + 4] = bflo(w.z); y[8 * j + 5] = bfhi(w.z); y[8 * j + 6] = bflo(w.w); y[8 * j + 7] = bfhi(w.w); }
#pragma unroll
        for (int i = 0; i < 32; ++i) ss += y[i] * y[i];
        const float rstd = rsqrtf(wave_sum_fast(ss) * (1.f / D) + EPS);
#pragma unroll
        for (int j = 0; j < 4; ++j) { const f32x4 ga = *(const f32x4*)(gpost + j * 512 + lane * 8), gb = *(const f32x4*)(gpost + j * 512 + lane * 8 + 4);
            x[8 * j + 0] += y[8 * j + 0] * rstd * ga.x; x[8 * j + 1] += y[8 * j + 1] * rstd * ga.y; x[8 * j + 2] += y[8 * j + 2] * rstd * ga.z; x[8 * j + 3] += y[8 * j + 3] * rstd * ga.w;
            x[8 * j + 4] += y[8 * j + 4] * rstd * gb.x; x[8 * j + 5] += y[8 * j + 5] * rstd * gb.y; x[8 * j + 6] += y[8 * j + 6] * rstd * gb.z; x[8 * j + 7] += y[8 * j + 7] * rstd * gb.w; }
    }
    if (xout) {
#pragma unroll
        for (int j = 0; j < 4; ++j) { *(f32x4*)(xout + j * 512 + lane * 8) = (f32x4){x[8 * j + 0], x[8 * j + 1], x[8 * j + 2], x[8 * j + 3]}; *(f32x4*)(xout + j * 512 + lane * 8 + 4) = (f32x4){x[8 * j + 4], x[8 * j + 5], x[8 * j + 6], x[8 * j + 7]}; }
    }
    if (hrow) {
        float ss = 0.f;
#pragma unroll
        for (int i = 0; i < 32; ++i) ss += x[i] * x[i];
        const float rstd = rsqrtf(wave_sum_fast(ss) * (1.f / D) + EPS);
#pragma unroll
        for (int j = 0; j < 4; ++j) { const f32x4 ga = *(const f32x4*)(gnext + j * 512 + lane * 8), gb = *(const f32x4*)(gnext + j * 512 + lane * 8 + 4);
            v4u o; o.x = pk2(x[8 * j + 0] * rstd * ga.x, x[8 * j + 1] * rstd * ga.y); o.y = pk2(x[8 * j + 2] * rstd * ga.z, x[8 * j + 3] * rstd * ga.w);
            o.z = pk2(x[8 * j + 4] * rstd * gb.x, x[8 * j + 5] * rstd * gb.y); o.w = pk2(x[8 * j + 6] * rstd * gb.z, x[8 * j + 7] * rstd * gb.w);
            *(v4u*)(hrow + j * 512 + lane * 8) = o; }
    }
}

typedef short bf16x8 __attribute__((ext_vector_type(8)));
typedef short s16x4 __attribute__((ext_vector_type(4)));
#ifndef ATT_DMA
#define ATT_DMA 0
#endif
struct ATask { const GAS bf16* Q; unsigned qst; const GAS bf16* K; const GAS bf16* V; unsigned kst; int jq0, jk0, nkeys, w, tlo, thi; float sd;
               bf16* O0; unsigned ost; float sink2; int has_sink; float* st; unsigned sst; };
__device__ __forceinline__ unsigned off_b(unsigned row, unsigned ch) { return 256u * row + 16u * (ch ^ (((row & 3) << 2) | ((row >> 2) & 3))); }
__device__ __forceinline__ float rows_max(float v) {
    auto a = __builtin_amdgcn_permlane16_swap(__float_as_uint(v), __float_as_uint(v), false, false); v = __builtin_fmaxf(__uint_as_float(a[0]), __uint_as_float(a[1]));
    auto b = __builtin_amdgcn_permlane32_swap(__float_as_uint(v), __float_as_uint(v), false, false); return __builtin_fmaxf(__uint_as_float(b[0]), __uint_as_float(b[1])); }
__device__ __forceinline__ float rows_sum(float v) {
    auto a = __builtin_amdgcn_permlane16_swap(__float_as_uint(v), __float_as_uint(v), false, false); v = __uint_as_float(a[0]) + __uint_as_float(a[1]);
    auto b = __builtin_amdgcn_permlane32_swap(__float_as_uint(v), __float_as_uint(v), false, false); return __uint_as_float(b[0]) + __uint_as_float(b[1]); }
struct MakeAtt { bf16* HB; bf16* YMIX; bf16* OP23; float* STATS; const float* sink;
    __device__ __forceinline__ void operator()(int id, ATask& T) const {
        const int ph = id / (M / 32), u = id % (M / 32);
        const bool dil = ph < 18;
        const int pi = dil ? ph / 6 : 0, hh = dil ? ph % 6 : ph - 18, dsh = !dil ? 0 : 2 * pi, d = 1 << dsh;
        const int gi = u >> dsh, r = u & (d - 1), g0 = gi * 32 * d, sb = seq_start_row(g0), n = (seq_end_row(g0) - sb) >> dsh;
        const int wband = dil ? 64 : 128, kvh = dil ? hh : hh / 3, nt = dil ? 5 : 9;
        const size_t row0 = (size_t)(g0 + r);
        T.Q = (const GAS bf16*)(HB + ((size_t)((dil ? 0 : 18) + hh) * M + row0) * HD); T.qst = (unsigned)d * HD;
        T.K = (const GAS bf16*)(HB + ((size_t)((dil ? 6 : 24) + kvh) * M + (size_t)(sb + r)) * HD); T.V = (const GAS bf16*)(HB + ((size_t)((dil ? 12 : 26) + kvh) * M + (size_t)(sb + r)) * HD); T.kst = (unsigned)d * HD;
        T.jq0 = (g0 - sb) >> dsh; T.jk0 = T.jq0 - wband; T.nkeys = n; T.w = wband;
        T.tlo = T.jk0 < 0 ? (-T.jk0) >> 5 : 0; T.thi = (T.jk0 + 32 * nt > n) ? (n - T.jk0) >> 5 : nt;
        T.sd = __builtin_amdgcn_exp2f(-8.f * (float)(hh + 1) / 6.f) * (float)d * 1.4426950408889634f;
        T.has_sink = dil ? 0 : 1; T.sink2 = dil ? 0.f : sink[hh] * 1.4426950408889634f;
        if (!dil) { T.O0 = YMIX + row0 * D + 1280 + hh * HD; T.ost = D; T.st = nullptr; T.sst = 0; }
        else { if (pi == 0) { T.O0 = YMIX + row0 * D + 512 + hh * HD; T.ost = D; } else { T.O0 = OP23 + (size_t)(pi - 1) * M * 768 + row0 * 768 + hh * HD; T.ost = (unsigned)d * 768; }
               T.st = STATS + ((row0 * 6 + hh) * 3 + pi) * 2; T.sst = (unsigned)d * 36; }
    }
};
struct MakeX { bf16* QBUF; bf16* MEMKV; bf16* OBUF;
    __device__ __forceinline__ void operator()(int id, ATask& T) const {
        const int hh = id / (M / 32), u = id % (M / 32), g0 = u * 32; const int b = g0 < MP ? (g0 >> 12) : NB_P;
        T.Q = (const GAS bf16*)(QBUF + (size_t)g0 * MEM_W + hh * HD); T.qst = MEM_W;
        T.K = (const GAS bf16*)(MEMKV + (size_t)b * NMEM * (2 * MEM_W) + hh * HD); T.V = T.K + MEM_W; T.kst = 2 * MEM_W;
        T.jq0 = 0; T.jk0 = 0; T.nkeys = NMEM; T.w = 0; T.tlo = 0; T.thi = NMEM / 32; T.sd = 0.f;
        T.O0 = OBUF + (size_t)g0 * MEM_W + hh * HD; T.ost = MEM_W; T.sink2 = 0.f; T.has_sink = 0; T.st = nullptr; T.sst = 0;
    }
};
template <bool BAND, class Maker>
__device__ __forceinline__ void attn_stream(const Maker& mk, int id0, int nid, int stride, LAS unsigned char* wl, int lane_in) {
    int id = id0; if (id >= nid) return;
    int lane = lane_in; asm volatile("" : "+v"(lane));
    const int fr = lane & 15, fq = lane >> 4, rr = lane >> 4, pc = lane & 15;
    const unsigned koff0_ = off_b(fr, fq), voff0_ = 8192u + off_b(4 * fq + (fr >> 2), (fr & 3) >> 1) + 8u * (fr & 1);
    const unsigned woff = off_b(rr, pc);
    ATask Tc, Tn; mk(id, Tc);
    bf16x8 qf[2][4]; v4u kreg[8], vreg[8];
#define ATT_UPTR(p) ((const GAS unsigned char*)(((unsigned long long)(unsigned)__builtin_amdgcn_readfirstlane((int)((unsigned long long)(p) >> 32)) << 32) | (unsigned long long)(unsigned)__builtin_amdgcn_readfirstlane((int)(unsigned)(unsigned long long)(p))))
#define ATT_ISSUE_Q(T_) do { const GAS unsigned char* q_ = ATT_UPTR((T_).Q); const unsigned qstb_ = (T_).qst * 2u, lq_ = (unsigned)fr * qstb_ + 16u * (unsigned)fq; \
        _Pragma("unroll") for (int qb = 0; qb < 2; ++qb) _Pragma("unroll") for (int s = 0; s < 4; ++s) \
        qf[qb][s] = *(const GAS bf16x8*)(q_ + (size_t)(16u * (unsigned)qb * qstb_ + 64u * (unsigned)s) + lq_); } while (0)
#define ATT_ISSUE(dst, T_, base, tt) do { const unsigned kstb_ = (T_).kst * 2u; const GAS unsigned char* p_ = ATT_UPTR((const GAS unsigned char*)(base) + (size_t)(unsigned)((T_).jk0 + 32 * (tt)) * kstb_); \
        const unsigned loff_ = ((unsigned)rr * (T_).kst + 8u * (unsigned)pc) * 2u; \
        _Pragma("unroll") for (int i = 0; i < 8; ++i) dst[i] = *(const GAS v4u*)(p_ + (size_t)(4u * (unsigned)i * kstb_) + loff_); } while (0)
    ATT_ISSUE_Q(Tc); ATT_ISSUE(kreg, Tc, Tc.K, Tc.tlo); ATT_ISSUE(vreg, Tc, Tc.V, Tc.tlo);
    for (;;) {
        const int idn = id + stride; const bool hn = idn < nid;
        if (hn) mk(idn, Tn); else Tn = Tc;
        f32x4 O[2][8]; float mrow[2], lrow[2];
#pragma unroll
        for (int qb = 0; qb < 2; ++qb) { mrow[qb] = -INFINITY; lrow[qb] = 0.f;
#pragma unroll
            for (int db = 0; db < 8; ++db) O[qb][db] = (f32x4){0.f, 0.f, 0.f, 0.f}; }
        asm volatile(".p2align 6" ::: "memory");
        for (int t = Tc.tlo; t < Tc.thi; ++t) {
            const bool last = (t + 1 == Tc.thi);
            unsigned koff0 = koff0_, voff0 = voff0_, wo = woff; asm volatile("" : "+v"(koff0), "+v"(voff0), "+v"(wo));
#pragma unroll
            for (int i = 0; i < 8; ++i) *(LAS v4u*)(wl + i * 1024 + (wo ^ (unsigned)((i & 3) << 4))) = kreg[i];
            if (!last) ATT_ISSUE(kreg, Tc, Tc.K, t + 1);
            asm volatile("s_waitcnt lgkmcnt(0)" ::: "memory");
            f32x4 S[2][2];
#pragma unroll
            for (int qb = 0; qb < 2; ++qb)
#pragma unroll
                for (int kb = 0; kb < 2; ++kb) S[qb][kb] = (f32x4){0.f, 0.f, 0.f, 0.f};
#pragma unroll
            for (int kb = 0; kb < 2; ++kb)
#pragma unroll
                for (int s = 0; s < 4; ++s) { const bf16x8 kf = *(const LAS bf16x8*)(wl + kb * 4096 + (koff0 ^ (unsigned)(s << 6)));
#pragma unroll
                    for (int qb = 0; qb < 2; ++qb) S[qb][kb] = __builtin_amdgcn_mfma_f32_16x16x32_bf16(kf, qf[qb][s], S[qb][kb], 0, 0, 0); }
            if (last && hn) { asm volatile("" : "+v"(S[0][0]), "+v"(S[0][1]), "+v"(S[1][0]), "+v"(S[1][1]));
                ATT_ISSUE_Q(Tn); ATT_ISSUE(kreg, Tn, Tn.K, Tn.tlo); }
            const int jt = Tc.jk0 + 32 * t;
            const bool interior = !BAND || (jt - (Tc.jq0 + 31) >= -Tc.w && jt + 31 - Tc.jq0 <= Tc.w);
            bf16x8 pb[2];
#pragma unroll
            for (int qb = 0; qb < 2; ++qb) {
                float v[8];
                const float fd0 = (float)(jt + 4 * fq - (Tc.jq0 + 16 * qb + fr));
                if (!BAND) {
#pragma unroll
                    for (int i = 0; i < 8; ++i) v[i] = S[qb][i >> 2][i & 3];
                } else if (interior) {
#pragma unroll
                    for (int i = 0; i < 8; ++i) { const float ad = __builtin_fabsf(fd0 + (float)(16 * (i >> 2) + (i & 3))); v[i] = S[qb][i >> 2][i & 3] - Tc.sd * ad; }
                } else {
#pragma unroll
                    for (int i = 0; i < 8; ++i) { const float ad = __builtin_fabsf(fd0 + (float)(16 * (i >> 2) + (i & 3)));
                        v[i] = (ad <= (float)Tc.w) ? S[qb][i >> 2][i & 3] - Tc.sd * ad : -INFINITY; }
                }
                float tm = __builtin_fmaxf(__builtin_fmaxf(__builtin_fmaxf(v[0], v[1]), __builtin_fmaxf(v[2], v[3])), __builtin_fmaxf(__builtin_fmaxf(v[4], v[5]), __builtin_fmaxf(v[6], v[7])));
                tm = rows_max(tm);
                if (__builtin_amdgcn_ballot_w64(tm > mrow[qb] + 8.f) != 0ull) {
                    const float mn = __builtin_fmaxf(mrow[qb], tm), msn = (mn == -INFINITY) ? 0.f : mn;
                    const float alpha = __builtin_amdgcn_exp2f(mrow[qb] - msn);
                    lrow[qb] *= alpha; mrow[qb] = mn;
#pragma unroll
                    for (int db = 0; db < 8; ++db) O[qb][db] = O[qb][db] * alpha;
                }
                const float ms = (mrow[qb] == -INFINITY) ? 0.f : mrow[qb];
                float rs = 0.f;
#pragma unroll
                for (int i = 0; i < 8; ++i) { v[i] = __builtin_amdgcn_exp2f(v[i] - ms); rs += v[i]; }
                rs = rows_sum(rs);
                lrow[qb] += rs;
                u32x4_t pk; pk.x = cvtpk_s(v[0], v[1]); pk.y = cvtpk_s(v[2], v[3]); pk.z = cvtpk_s(v[4], v[5]); pk.w = cvtpk_s(v[6], v[7]);
                pb[qb] = __builtin_bit_cast(bf16x8, pk);
            }
#pragma unroll
            for (int i = 0; i < 8; ++i) *(LAS v4u*)(wl + 8192 + i * 1024 + (wo ^ (unsigned)((i & 3) << 4))) = vreg[i];
            if (!last) ATT_ISSUE(vreg, Tc, Tc.V, t + 1); else if (hn) ATT_ISSUE(vreg, Tn, Tn.V, Tn.tlo);
            asm volatile("s_waitcnt lgkmcnt(0)" ::: "memory");
#pragma unroll
            for (int db = 0; db < 8; ++db) {
                const unsigned vo = voff0 ^ (unsigned)(db << 5);
                const s16x4 lo = __builtin_bit_cast(s16x4, __builtin_amdgcn_ds_read_tr16_b64_v4i16((LAS s16x4*)(wl + vo)));
                const s16x4 hi = __builtin_bit_cast(s16x4, __builtin_amdgcn_ds_read_tr16_b64_v4i16((LAS s16x4*)(wl + 4096 + vo)));
                const bf16x8 vf = __builtin_shufflevector(lo, hi, 0, 1, 2, 3, 4, 5, 6, 7);
#pragma unroll
                for (int qb = 0; qb < 2; ++qb) O[qb][db] = __builtin_amdgcn_mfma_f32_16x16x32_bf16(vf, pb[qb], O[qb][db], 0, 0, 0);
            }
        }
#pragma unroll
        for (int qb = 0; qb < 2; ++qb) {
            const unsigned i = 16u * qb + (unsigned)fr;
            const float den = Tc.has_sink ? lrow[qb] + __builtin_amdgcn_exp2f(Tc.sink2 - mrow[qb]) : lrow[qb];
            const float inv = 1.f / den;
            bf16* orow = Tc.O0 + (size_t)(i * Tc.ost);
#pragma unroll
            for (int db = 0; db < 8; ++db) { v2u w; w.x = cvtpk_s(O[qb][db][0] * inv, O[qb][db][1] * inv); w.y = cvtpk_s(O[qb][db][2] * inv, O[qb][db][3] * inv);
                *(v2u*)(orow + 16 * db + 4 * fq) = w; }
            if (Tc.st && fq == 0) *(float2*)(Tc.st + (size_t)(i * Tc.sst)) = make_float2(mrow[qb], lrow[qb]);
        }
        if (!hn) break;
        Tc = Tn; id = idn;
    }
#undef ATT_ISSUE
#undef ATT_ISSUE_Q
#undef ATT_UPTR
}

template <int MODE>
__device__ __forceinline__ void rows_split(const float* xin_p, const float* xin_s, bf16* XH, const bf16* Y, const float* gpost, float* RSTD, float* OUT, int gw, int NGW, int lane) {
    f32x4 gp[8];
#pragma unroll
    for (int j = 0; j < 8; ++j) gp[j] = (MODE != 0) ? *(const f32x4*)(gpost + 256 * j + 4 * lane) : (f32x4){0.f, 0.f, 0.f, 0.f};
    f32x4 fa[8], fb[8], fc[8]; v2u ha[8], ya[8], hb[8], yb[8], hc[8], yc[8];
#define ROWS_LOAD(mm, F_, H_, Y_) do { if (MODE == 0) { const float* src_ = (mm) < MP ? xin_p + (size_t)(mm) * D : xin_s + (size_t)((mm) - MP) * D; \
            _Pragma("unroll") for (int j = 0; j < 8; ++j) F_[j] = __builtin_nontemporal_load((const f32x4*)(src_ + 256 * j + 4 * lane)); } \
        else { _Pragma("unroll") for (int j = 0; j < 8; ++j) { H_[j] = *(const v2u*)(XH + (size_t)(mm) * D + 256 * j + 4 * lane); \
            Y_[j] = __builtin_nontemporal_load((const v2u*)(Y + (size_t)(mm) * D + 256 * j + 4 * lane)); } } } while (0)
#pragma unroll
    for (int j = 0; j < 8; ++j) { fa[j] = fb[j] = fc[j] = (f32x4){0.f, 0.f, 0.f, 0.f}; ha[j] = hb[j] = hc[j] = (v2u){0u, 0u}; ya[j] = yb[j] = yc[j] = (v2u){0u, 0u}; }
    int m = gw; float inva = 0.f, invb = 0.f, invc = 0.f;
    if (m < M) { ROWS_LOAD(m, fa, ha, ya); if (MODE != 0) inva = RSTD[m]; }
    if (m + NGW < M) { ROWS_LOAD(m + NGW, fb, hb, yb); if (MODE != 0) invb = RSTD[m + NGW]; }
    for (; m < M; m += NGW) {
        const int mn = m + 2 * NGW;
        if (mn < M) { ROWS_LOAD(mn, fc, hc, yc); if (MODE != 0) invc = RSTD[mn]; }
        f32x4 x[8]; float s2 = 0.f;
        if (MODE == 0) {
#pragma unroll
            for (int j = 0; j < 8; ++j) x[j] = fa[j];
        } else {
            f32x4 y[8]; float ss = 0.f;
#pragma unroll
            for (int j = 0; j < 8; ++j) { y[j] = (f32x4){bflo(ya[j].x), bfhi(ya[j].x), bflo(ya[j].y), bfhi(ya[j].y)}; ss += (y[j].x * y[j].x + y[j].y * y[j].y) + (y[j].z * y[j].z + y[j].w * y[j].w); }
            const float rstd = rsqrtf(wave_sum_fast(ss) * (1.f / D) + EPS);
#pragma unroll
            for (int j = 0; j < 8; ++j) { const f32x4 xh = (f32x4){bflo(ha[j].x), bfhi(ha[j].x), bflo(ha[j].y), bfhi(ha[j].y)};
                x[j] = xh * inva + y[j] * rstd * gp[j]; }
        }
        if (MODE == 2) {
#pragma unroll
            for (int j = 0; j < 8; ++j) __builtin_nontemporal_store(x[j], (f32x4*)(OUT + (size_t)m * D + 256 * j + 4 * lane));
        } else {
#pragma unroll
            for (int j = 0; j < 8; ++j) s2 += (x[j].x * x[j].x + x[j].y * x[j].y) + (x[j].z * x[j].z + x[j].w * x[j].w);
            const float ms = wave_sum_fast(s2) * (1.f / D) + EPS, r2 = rsqrtf(ms), inv = 1.f / r2;
#pragma unroll
            for (int j = 0; j < 8; ++j) { const f32x4 xs = x[j] * r2;
                v2u h; h.x = cvtpk_s(xs.x, xs.y); h.y = cvtpk_s(xs.z, xs.w);
                *(v2u*)(XH + (size_t)m * D + 256 * j + 4 * lane) = h; }
            if (lane == 0) RSTD[m] = inv;
        }
#pragma unroll
        for (int j = 0; j < 8; ++j) { fa[j] = fb[j]; ha[j] = hb[j]; ya[j] = yb[j]; fb[j] = fc[j]; hb[j] = hc[j]; yb[j] = yc[j]; }
        inva = invb; invb = invc;
    }
#undef ROWS_LOAD
}

struct Args { const float* in[28]; float* out; unsigned char* ws; int ph_lo, ph_hi, mask, sync; };
static_assert(sizeof(Args) == 28 * 8 + 8 + 8 + 16, "Args has no padding");

__global__ void __launch_bounds__(NWAVES * 64, 2) trunk_fwd(Args args) {
    extern __shared__ __attribute__((aligned(16))) unsigned char lds[];
    LAS unsigned char* L = (LAS unsigned char*)lds;
    volatile LAS unsigned* MISC = (volatile LAS unsigned*)(L + MISC_OFF);
    const int tid0 = threadIdx.x;
    const int G0 = gridDim.x, bid0 = blockIdx.x, wave0 = __builtin_amdgcn_readfirstlane(tid0 >> 6);
    { gu32* ctl0 = (gu32*)(args.ws + WS_CTL); (void)ctl0; }
    for (int u = tid0; u < (LDS_BYTES - LDSCTL_OFF) / 4; u += NWAVES * 64) ((LAS unsigned*)(L + LDSCTL_OFF))[u] = 0u;
    __syncthreads();
    XcdBarrier bar; bar.bar = (unsigned*)((gu32*)(args.ws + WS_CTL) + CW_BAR); bar.x = 0; bar.st = nullptr;
    if (args.sync) bar = xcd_barrier_post((unsigned*)((gu32*)(args.ws + WS_CTL) + CW_BAR), MISC + 8);
    const int lo = args.ph_lo, hi = args.ph_hi;
    const int pmask = args.mask, psync = args.sync;
#define IN(k) (((pmask >> ((k) % NP)) & 1) && lo <= (k) && (k) < hi)
#define SEAM(k) do { if (psync && lo <= (k) && (k) + 1 < hi) xcd_barrier(bar); } while (0)

#pragma unroll 1
    for (int l = 0; l < DEPTH; ++l) {
        const int pb = l * NP;
        unsigned char* ws = args.ws; float* X = args.out;
        asm volatile("" : "+s"(ws), "+s"(X));
#define PHASE_IDS() unsigned ones_ = ~0u; int wave = wave0, G = G0, bid = bid0; asm volatile("" : "+s"(ones_), "+s"(wave), "+s"(G), "+s"(bid)); const int lane = (int)__builtin_amdgcn_mbcnt_hi(ones_, __builtin_amdgcn_mbcnt_lo(ones_, 0u)); const int tid = wave * 64 + lane; const int gw = bid * NWAVES + wave, NGW = G * NWAVES; (void)lane; (void)gw; (void)NGW; (void)tid
        const float* x_prompt = args.in[0]; const float* x_sample = args.in[1]; const float* mem_prompt = args.in[2]; const float* mem_sample = args.in[3];
        bf16* WIN_T = (bf16*)(ws + WS_WIN); bf16* WOUT_T = (bf16*)(ws + WS_WOUT); bf16* WMQ_T = (bf16*)(ws + WS_WMQ); bf16* WMKV_T = (bf16*)(ws + WS_WMKV);
        bf16* WMO_T = (bf16*)(ws + WS_WMO); bf16* WG_T = (bf16*)(ws + WS_WG); bf16* W1_T = (bf16*)(ws + WS_W1); bf16* W2_T = (bf16*)(ws + WS_W2);
        bf16* MEMN = (bf16*)(ws + WS_MEMN); bf16* MEMKV = (bf16*)(ws + WS_MEMKV); float* AGG = (float*)(ws + WS_AGG2); float* BAGG = (float*)(ws + WS_CAR); float* BC = (float*)(ws + WS_CAR + 5 * MiB); float* GBIAS = (float*)(ws + WS_GBIAS);
        bf16* XC = (bf16*)((unsigned char*)X + OUT_XC); bf16* XH = (bf16*)(ws + WS_XH); float* RSTD = (float*)(ws + WS_RSTD); bf16* YBUF = (bf16*)(ws + WS_YBUF); bf16* PA = (bf16*)(ws + WS_PROJ); bf16* HB = PA + (size_t)M * PA_W;
        bf16* UBUF = (bf16*)(ws + WS_U); bf16* QBUF = (bf16*)(ws + WS_Q); bf16* OBUF = (bf16*)(ws + WS_O);
        bf16* GATES = YBUF;
        bf16* YMIX = (bf16*)((unsigned char*)X + OUT_YMIX);
        constexpr int I_IN = (D / 64) * (IN_W / 64), I_OUT = (D / 64) * (D / 64), I_MQ = (D / 64) * (MEM_W / 64), I_MO = (MEM_W / 64) * (D / 64), I_1 = (D / 64) * (DFF / 64), I_2 = (DFF / 64) * (D / 64);
        constexpr int NITEMS = I_IN + I_OUT + 3 * I_MQ + I_MO + I_1 + I_2;
#define TDECODE(t, it_) do { int r_ = (it_); \
                if (r_ < I_IN) { t.W = w_in; t.WT = WIN_T; t.K = D; t.N = IN_W; t.row_off = 0; t.gk = args.in[4] + (size_t)l * D; } \
                else if ((r_ -= I_IN) < I_OUT) { t.W = w_out; t.WT = WOUT_T; t.K = D; t.N = D; t.row_off = 0; t.gk = nullptr; } \
                else if ((r_ -= I_OUT) < I_MQ) { t.W = w_mq; t.WT = WMQ_T; t.K = D; t.N = MEM_W; t.row_off = 0; t.gk = args.in[17] + (size_t)l * D; } \
                else if ((r_ -= I_MQ) < I_MQ) { t.W = w_mk; t.WT = WMKV_T; t.K = D; t.N = MEM_W; t.row_off = 0; t.gk = nullptr; } \
                else if ((r_ -= I_MQ) < I_MQ) { t.W = w_mv; t.WT = WMKV_T; t.K = D; t.N = MEM_W; t.row_off = MEM_W; t.gk = nullptr; } \
                else if ((r_ -= I_MQ) < I_MO) { t.W = w_mo; t.WT = WMO_T; t.K = MEM_W; t.N = D; t.row_off = 0; t.gk = nullptr; } \
                else if ((r_ -= I_MO) < I_1) { t.W = w_ff1; t.WT = W1_T; t.K = D; t.N = DFF; t.row_off = 0; t.gk = args.in[24] + (size_t)l * D; } \
                else { r_ -= I_1; t.W = w_ff2; t.WT = W2_T; t.K = DFF; t.N = D; t.row_off = 0; t.gk = nullptr; } \
                const int nblk_ = t.N / 64; t.k0 = 64 * (r_ / nblk_); t.n0 = 64 * (r_ % nblk_); \
                t.cs = ((t.WT == WIN_T && ((t.n0 >= C_QB && t.n0 < C_KB) || (t.n0 >= C_QC && t.n0 < C_KC))) || t.WT == WMQ_T) ? QSCALE2 : 1.f; } while (0)
        constexpr int N_EARLY = NITEMS - I_1 - I_2 - I_MO, N_DEF_PROJ = 3680;
#define CONV_RANGE(I0_, I1_, W0_, NW_) do { \
            const float* w_in = args.in[6] + (size_t)l * D * IN_W; const float* w_out = args.in[16] + (size_t)l * D * D; \
            const float* w_mq = args.in[20] + (size_t)l * D * MEM_W; const float* w_mk = args.in[21] + (size_t)l * D * MEM_W; const float* w_mv = args.in[22] + (size_t)l * D * MEM_W; \
            const float* w_mo = args.in[23] + (size_t)l * MEM_W * D; const float* w_ff1 = args.in[26] + (size_t)l * D * DFF; const float* w_ff2 = args.in[27] + (size_t)l * DFF * D; \
            LAS float* scr64 = (LAS float*)(L + wave * 16640); \
            for (int it = (I0_) + (W0_); it < (I1_); it += (NW_)) { TItem ta; f32x4 va[16]; TDECODE(ta, it); titem_load(ta, lane, va); titem_store(ta, lane, va, scr64); } } while (0)
        if (IN(pb + P_CONV)) { PHASE_IDS();
            LAS float* scr = (LAS float*)(L + RING_OFF + wave * 16384);
            CONV_RANGE(0, (G == 256) ? N_EARLY : NITEMS, gw, NGW);
            for (int i = bid * 512 + tid; i < 2048 * 16; i += G * 512) {
                const int row = i >> 4, k0 = (i & 15) * 8, gi = row & 3, cch = row >> 2, n = cch >> 7, e = cch & 127;
                const float* wsrc = ((gi & 1) ? args.in[11] : args.in[9]) + ((size_t)((l * 2 + (gi >> 1)) * 4 + n)) * 16384 + (size_t)k0 * 128 + e;
                v4u o; o.x = pk2(wsrc[0], wsrc[128]); o.y = pk2(wsrc[256], wsrc[384]); o.z = pk2(wsrc[512], wsrc[640]); o.w = pk2(wsrc[768], wsrc[896]);
                *(v4u*)(WG_T + (size_t)row * 128 + k0) = o;
            }
            for (int i = bid * 512 + tid; i < 2048; i += G * 512) { const int gi = i & 3, c = i >> 2;
                GBIAS[i] = ((gi & 1) ? args.in[12] : args.in[10])[(size_t)(l * 2 + (gi >> 1)) * 512 + c]; }
            for (int r = gw; r < MMEM; r += NGW) {
                const float* src = r < NB_P * NMEM ? mem_prompt + (size_t)r * D : mem_sample + (size_t)(r - NB_P * NMEM) * D;
                row_pass(src, nullptr, nullptr, nullptr, args.in[19] + (size_t)l * D, MEMN + (size_t)r * D, lane);
            }
            if (l == 0) rows_split<0>(x_prompt, x_sample, XH, nullptr, nullptr, RSTD, nullptr, gw, NGW, lane);
        }
        SEAM(pb + P_CONV);
        if (IN(pb + P_PROJ)) { PHASE_IDS();
            { pg8::Gemm g{XH, WIN_T, M, IN_W, D}; pg8::StaticOrder S; S.init(M, IN_W, G, bid); EpiProj E{PA, HB};
              pg8::gemm_phase<EpiProj, pg8::StaticOrder, true, true>(L + RING_OFF, g, S, E, tid); }
            { pg8::Gemm g{MEMN, WMKV_T, MMEM, 2 * MEM_W, D}; pg8::StaticOrder S; S.init(MMEM, 2 * MEM_W, G, (bid + 128) % G); pg8::EpiBf16<0> E{MEMKV, 2 * MEM_W, nullptr};
              pg8::gemm_phase<pg8::EpiBf16<0>, pg8::StaticOrder, true, true>(L + RING_OFF, g, S, E, tid); }
            if (G == 256 && bid >= 164) CONV_RANGE(N_EARLY, N_EARLY + N_DEF_PROJ, (bid - 164) * NWAVES + wave, (256 - 164) * NWAVES);
        }
        SEAM(pb + P_PROJ);
        if (IN(pb + P_XC)) { PHASE_IDS();
            const float* cw = args.in[7] + (size_t)l * 4 * LRU_W; const float* cb = args.in[8] + (size_t)l * LRU_W;
            for (int i = bid * 512 + tid; i < (M / 4) * 64; i += G * 512) {
                const int m0 = (i >> 6) * 4, c0 = (i & 63) * 8; const int s0 = seq_start_row(m0), s1 = seq_end_row(m0);
                v4u w[7];
#pragma unroll
                for (int j = 0; j < 7; ++j) { const int r = m0 + j - 2; w[j] = (r >= s0 && r < s1) ? *(const v4u*)(PA + (size_t)r * PA_W + C_XA + c0) : (v4u){0u, 0u, 0u, 0u}; }
                float cwv[4][8], cbv[8];
#pragma unroll
                for (int j = 0; j < 4; ++j) { const f32x4 a = *(const f32x4*)(cw + j * LRU_W + c0), b = *(const f32x4*)(cw + j * LRU_W + c0 + 4);
                    cwv[j][0] = a.x; cwv[j][1] = a.y; cwv[j][2] = a.z; cwv[j][3] = a.w; cwv[j][4] = b.x; cwv[j][5] = b.y; cwv[j][6] = b.z; cwv[j][7] = b.w; }
                { const f32x4 a = *(const f32x4*)(cb + c0), b = *(const f32x4*)(cb + c0 + 4); cbv[0] = a.x; cbv[1] = a.y; cbv[2] = a.z; cbv[3] = a.w; cbv[4] = b.x; cbv[5] = b.y; cbv[6] = b.z; cbv[7] = b.w; }
#pragma unroll
                for (int q = 0; q < 4; ++q) {
                    float acc[8];
#pragma unroll
                    for (int e = 0; e < 8; ++e) acc[e] = cbv[e];
#pragma unroll
                    for (int j = 0; j < 4; ++j) { const v4u ww = w[q + j];
                        acc[0] += cwv[j][0] * bflo(ww.x); acc[1] += cwv[j][1] * bfhi(ww.x); acc[2] += cwv[j][2] * bflo(ww.y); acc[3] += cwv[j][3] * bfhi(ww.y);
                        acc[4] += cwv[j][4] * bflo(ww.z); acc[5] += cwv[j][5] * bfhi(ww.z); acc[6] += cwv[j][6] * bflo(ww.w); acc[7] += cwv[j][7] * bfhi(ww.w); }
                    v4u o; o.x = cvtpk_s(acc[0], acc[1]); o.y = cvtpk_s(acc[2], acc[3]); o.z = cvtpk_s(acc[4], acc[5]); o.w = cvtpk_s(acc[6], acc[7]);
                    *(v4u*)(XC + (size_t)(m0 + q) * LRU_W + c0) = o;
                }
            }
        }
        SEAM(pb + P_XC);
        if (IN(pb + P_GATES)) { PHASE_IDS();
            pg8::Gemm g{XC, WG_T, M, 2048, LRU_W}; pg8::StaticOrder S; S.init(M, 2048, G, bid); EpiLU E{GATES, XC, GBIAS, args.in[13] + (size_t)l * 2 * 512};
            pg8::gemm_phase<EpiLU, pg8::StaticOrder, true, true, 128>(L + RING_OFF, g, S, E, tid);
        }
        SEAM(pb + P_GATES);
        if (IN(pb + P_AGG)) { PHASE_IDS();
            LAS float* SA = (LAS float*)(L + RING_OFF);
            for (int wu = bid; wu < (M / 256) * 4; wu += G) {
                const int bk = wu >> 2, ci = bk * 8 + wave, c0 = (wu & 3) * 128 + 2 * lane;
                float Af[2] = {1.f, 1.f}, Hf[2] = {0.f, 0.f}, Pb[2] = {1.f, 1.f}, Hb[2] = {0.f, 0.f};
                const bf16* lp = GATES + ((size_t)ci * LCH * LRU_W + c0) * 4;
#pragma unroll
                for (int hh = 0; hh < 2; ++hh) {
                    v4u w[16];
#pragma unroll
                    for (int t = 0; t < 16; ++t) w[t] = *(const v4u*)(lp + (size_t)(hh * 16 + t) * (LRU_W * 4));
#pragma unroll
                    for (int t = 0; t < 16; ++t) {
                        float a;
                        a = __builtin_amdgcn_exp2f(bflo(w[t].x)); Hf[0] = a * Hf[0] + bfhi(w[t].x); Af[0] *= a;
                        a = __builtin_amdgcn_exp2f(bflo(w[t].z)); Hf[1] = a * Hf[1] + bfhi(w[t].z); Af[1] *= a;
                        a = __builtin_amdgcn_exp2f(bflo(w[t].y)); Hb[0] += Pb[0] * bfhi(w[t].y); Pb[0] *= a;
                        a = __builtin_amdgcn_exp2f(bflo(w[t].w)); Hb[1] += Pb[1] * bfhi(w[t].w); Pb[1] *= a;
                    }
                }
                { LAS f32x4* s4 = (LAS f32x4*)(SA + (wave * 64 + lane) * 8); s4[0] = (f32x4){Af[0], Hf[0], Af[1], Hf[1]}; s4[1] = (f32x4){Pb[0], Hb[0], Pb[1], Hb[1]}; }
                __syncthreads();
                float Alf[2] = {1.f, 1.f}, Hlf[2] = {0.f, 0.f}, Alb[2] = {1.f, 1.f}, Hlb[2] = {0.f, 0.f};
                for (int j = 0; j < wave; ++j) { const f32x4 v = *(const LAS f32x4*)(SA + (j * 64 + lane) * 8);
                    Hlf[0] = v.x * Hlf[0] + v.y; Alf[0] *= v.x; Hlf[1] = v.z * Hlf[1] + v.w; Alf[1] *= v.z; }
                for (int j = 7; j > wave; --j) { const f32x4 v = *(const LAS f32x4*)(SA + (j * 64 + lane) * 8 + 4);
                    Hlb[0] = v.x * Hlb[0] + v.y; Alb[0] *= v.x; Hlb[1] = v.z * Hlb[1] + v.w; Alb[1] *= v.z; }
                *(f32x4*)(AGG + ((size_t)(ci * 2 + 0) * 512 + c0) * 2) = (f32x4){Alf[0], Hlf[0], Alf[1], Hlf[1]};
                *(f32x4*)(AGG + ((size_t)(ci * 2 + 1) * 512 + c0) * 2) = (f32x4){Alb[0], Hlb[0], Alb[1], Hlb[1]};
                const int sq = bk < 128 ? (bk >> 4) : 8, bis = bk < 128 ? (bk & 15) : bk - 128;
                if (wave == 7) {
#pragma unroll
                    for (int e = 0; e < 2; ++e) *(float2*)(BAGG + (((size_t)(sq * 2 + 0) * 512 + c0 + e) * 64 + bis) * 2) = make_float2(Af[e] * Alf[e], Af[e] * Hlf[e] + Hf[e]);
                }
                if (wave == 0) {
#pragma unroll
                    for (int e = 0; e < 2; ++e) *(float2*)(BAGG + (((size_t)(sq * 2 + 1) * 512 + c0 + e) * 64 + bis) * 2) = make_float2(Pb[e] * Alb[e], Pb[e] * Hlb[e] + Hb[e]);
                }
                __syncthreads();
            }
        }
        SEAM(pb + P_AGG);
        if (IN(pb + P_CARRY)) { PHASE_IDS();
            for (int id = gw; id < NSEQ * 2 * 512; id += NGW) {
                const int dr = (id >> 9) & 1, s = id >> 10, nb = s < NB_P ? SEQ_P / 256 : SEQ_S / 256;
                const int blk = dr ? nb - 1 - lane : lane; const bool ok = lane < nb;
                float A = 1.f, H = 0.f;
                if (ok) { const float2 ah = *(const float2*)(BAGG + ((size_t)id * 64 + blk) * 2); A = ah.x; H = ah.y; }
#pragma unroll
                for (int off = 1; off < 64; off <<= 1) { const int src = ((lane - off) & 63) << 2;
                    const float Ap = __builtin_bit_cast(float, __builtin_amdgcn_ds_bpermute(src, __builtin_bit_cast(int, A))), Hp = __builtin_bit_cast(float, __builtin_amdgcn_ds_bpermute(src, __builtin_bit_cast(int, H)));
                    if (lane >= off) { H = A * Hp + H; A = A * Ap; } }
                const float cin = __builtin_bit_cast(float, __builtin_amdgcn_ds_bpermute(((lane - 1) & 63) << 2, __builtin_bit_cast(int, H)));
                if (ok) BC[(size_t)id * 64 + blk] = lane == 0 ? 0.f : cin;
            }
        }
        SEAM(pb + P_CARRY);
        if (IN(pb + P_LRU)) { PHASE_IDS();
            for (int u = gw; u < NCHK * 4; u += NGW) {
                const int ci = u >> 2, c0 = (u & 3) * 128 + 2 * lane;
                const int bk = ci >> 3, sq = bk < 128 ? (bk >> 4) : 8, bis = bk < 128 ? (bk & 15) : bk - 128;
                const f32x4 lf = *(const f32x4*)(AGG + ((size_t)(ci * 2 + 0) * 512 + c0) * 2), lb = *(const f32x4*)(AGG + ((size_t)(ci * 2 + 1) * 512 + c0) * 2);
                float hf0 = lf.x * BC[((size_t)(sq * 2 + 0) * 512 + c0) * 64 + bis] + lf.y, hf1 = lf.z * BC[((size_t)(sq * 2 + 0) * 512 + c0 + 1) * 64 + bis] + lf.w;
                float hb0 = lb.x * BC[((size_t)(sq * 2 + 1) * 512 + c0) * 64 + bis] + lb.y, hb1 = lb.z * BC[((size_t)(sq * 2 + 1) * 512 + c0 + 1) * 64 + bis] + lb.w;
                const bf16* lp = GATES + ((size_t)ci * LCH * LRU_W + c0) * 4;
                const bf16* pp = PA + (size_t)ci * LCH * PA_W + C_GATE + c0; bf16* yp = YMIX + (size_t)ci * LCH * D + c0;
                float hv0[LCH], hv1[LCH]; v4u w[LCH]; unsigned gt[LCH];
#pragma unroll
                for (int hh = 0; hh < 2; ++hh) {
#pragma unroll
                  for (int t = 0; t < 16; ++t) { const int tt = hh * 16 + t; w[tt] = __builtin_nontemporal_load((const v4u*)(lp + (size_t)tt * (LRU_W * 4))); gt[tt] = *(const unsigned*)(pp + (size_t)tt * PA_W); }
#pragma unroll
                  for (int t = 0; t < 16; ++t) { const int tt = hh * 16 + t; float a;
                    a = __builtin_amdgcn_exp2f(bflo(w[tt].x)); hf0 = a * hf0 + bfhi(w[tt].x); hv0[tt] = hf0;
                    a = __builtin_amdgcn_exp2f(bflo(w[tt].z)); hf1 = a * hf1 + bfhi(w[tt].z); hv1[tt] = hf1; } }
#pragma unroll
                for (int tt = LCH - 1; tt >= 0; --tt) { float a;
                    a = __builtin_amdgcn_exp2f(bflo(w[tt].y)); hb0 = a * hb0 + bfhi(w[tt].y);
                    a = __builtin_amdgcn_exp2f(bflo(w[tt].w)); hb1 = a * hb1 + bfhi(w[tt].w);
                    *(unsigned*)(yp + (size_t)tt * D) = pk2((hv0[tt] + hb0) * fgelu(bflo(gt[tt])), (hv1[tt] + hb1) * fgelu(bfhi(gt[tt]))); }
            }
        }
        SEAM(pb + P_LRU);
        if (IN(pb + P_ATT)) { PHASE_IDS();
            LAS unsigned char* wl = L + RING_OFF + wave * 16384;
            const int vcu = (G % 8 == 0) ? (bid % 8) * (G / 8) + bid / 8 : bid;
            MakeAtt mk{HB, YMIX, YBUF  , (float*)(YBUF + (size_t)2 * M * 768)  , args.in[14] + l * 6};
            attn_stream<true, MakeAtt>(mk, vcu * NWAVES + wave, 24 * (M / 32), NGW, wl, lane);
        }
        SEAM(pb + P_ATT);
        if (IN(pb + P_COMB)) { PHASE_IDS();
            const float* gn = args.in[15] + (size_t)l * D;
            const bf16* OP23 = YBUF; const float* STATS = (const float*)(YBUF + (size_t)2 * M * 768);
            const int half = lane >> 5, ci = (lane & 31) * 4;
            f32x4 gB[3], gC[3], gA0, gA1;
#pragma unroll
            for (int j = 0; j < 3; ++j) { gB[j] = *(const f32x4*)(gn + 512 + (2 * j + half) * HD + ci); gC[j] = *(const f32x4*)(gn + 1280 + (2 * j + half) * HD + ci); }
            gA0 = *(const f32x4*)(gn + 8 * lane); gA1 = *(const f32x4*)(gn + 8 * lane + 4);
#define COMB_LOAD(mm, A_, B_, C_, E_, S1_, S2_, S3_, WA_) do { const bf16* yr_ = YMIX + (size_t)(mm) * D; \
                _Pragma("unroll") for (int j = 0; j < 3; ++j) { const int hh = 2 * j + half; \
                    A_[j] = *(const v2u*)(yr_ + 512 + hh * HD + ci); B_[j] = *(const v2u*)(OP23 + (size_t)(mm) * 768 + hh * HD + ci); \
                    C_[j] = *(const v2u*)(OP23 + (size_t)M * 768 + (size_t)(mm) * 768 + hh * HD + ci); E_[j] = *(const v2u*)(yr_ + 1280 + hh * HD + ci); \
                    const float* st = STATS + ((size_t)(mm) * 6 + hh) * 6; S1_[j] = *(const float2*)st; S2_[j] = *(const float2*)(st + 2); S3_[j] = *(const float2*)(st + 4); } \
                WA_ = *(const v4u*)(yr_ + 8 * lane); } while (0)
            v2u a[3], b[3], c[3], e[3]; float2 s1[3], s2[3], s3[3]; v4u wa = (v4u){0u, 0u, 0u, 0u};
#pragma unroll
            for (int j = 0; j < 3; ++j) { a[j] = b[j] = c[j] = e[j] = (v2u){0u, 0u}; s1[j] = s2[j] = s3[j] = make_float2(0.f, 1.f); }
            if (gw < M) COMB_LOAD(gw, a, b, c, e, s1, s2, s3, wa);
            for (int m = gw; m < M; m += NGW) {
                bf16* yrow = YMIX + (size_t)m * D;
                const int mn = m + NGW;
                v2u an[3], bn[3], cn[3], en[3]; float2 s1n[3], s2n[3], s3n[3]; v4u wan = (v4u){0u, 0u, 0u, 0u};
#pragma unroll
                for (int j = 0; j < 3; ++j) { an[j] = bn[j] = cn[j] = en[j] = (v2u){0u, 0u}; s1n[j] = s2n[j] = s3n[j] = make_float2(0.f, 1.f); }
                if (mn < M) COMB_LOAD(mn, an, bn, cn, en, s1n, s2n, s3n, wan);
                float vb[3][4], vc[3][4]; float ssb = 0.f, ssc = 0.f;
#pragma unroll
                for (int j = 0; j < 3; ++j) {
                    const float mm = fmaxf(s1[j].x, fmaxf(s2[j].x, s3[j].x));
                    const float w1 = s1[j].y * __builtin_amdgcn_exp2f(s1[j].x - mm), w2 = s2[j].y * __builtin_amdgcn_exp2f(s2[j].x - mm), w3 = s3[j].y * __builtin_amdgcn_exp2f(s3[j].x - mm);
                    const float inv = __builtin_amdgcn_rcpf(w1 + w2 + w3);
                    const float u1 = w1 * inv, u2 = w2 * inv, u3 = w3 * inv;
                    vb[j][0] = u1 * bflo(a[j].x) + u2 * bflo(b[j].x) + u3 * bflo(c[j].x); vb[j][1] = u1 * bfhi(a[j].x) + u2 * bfhi(b[j].x) + u3 * bfhi(c[j].x);
                    vb[j][2] = u1 * bflo(a[j].y) + u2 * bflo(b[j].y) + u3 * bflo(c[j].y); vb[j][3] = u1 * bfhi(a[j].y) + u2 * bfhi(b[j].y) + u3 * bfhi(c[j].y);
                    vc[j][0] = bflo(e[j].x); vc[j][1] = bfhi(e[j].x); vc[j][2] = bflo(e[j].y); vc[j][3] = bfhi(e[j].y);
#pragma unroll
                    for (int q = 0; q < 4; ++q) { ssb += vb[j][q] * vb[j][q]; ssc += vc[j][q] * vc[j][q]; }
                }
                float y[8] = {bflo(wa.x), bfhi(wa.x), bflo(wa.y), bfhi(wa.y), bflo(wa.z), bfhi(wa.z), bflo(wa.w), bfhi(wa.w)}; float ssa = 0.f;
#pragma unroll
                for (int q = 0; q < 8; ++q) ssa += y[q] * y[q];
                const float rb = rsqrtf(wave_sum_fast(ssb) * (1.f / 768.f) + EPS), rc = rsqrtf(wave_sum_fast(ssc) * (1.f / 768.f) + EPS), ra = rsqrtf(wave_sum_fast(ssa) * (1.f / 512.f) + EPS);
                { v4u o; o.x = cvtpk_s(y[0] * ra * gA0.x, y[1] * ra * gA0.y); o.y = cvtpk_s(y[2] * ra * gA0.z, y[3] * ra * gA0.w); o.z = cvtpk_s(y[4] * ra * gA1.x, y[5] * ra * gA1.y); o.w = cvtpk_s(y[6] * ra * gA1.z, y[7] * ra * gA1.w);
                  *(v4u*)(yrow + 8 * lane) = o; }
#pragma unroll
                for (int j = 0; j < 3; ++j) { const int hh = 2 * j + half;
                    v2u ob, oc; ob.x = cvtpk_s(vb[j][0] * rb * gB[j].x, vb[j][1] * rb * gB[j].y); ob.y = cvtpk_s(vb[j][2] * rb * gB[j].z, vb[j][3] * rb * gB[j].w);
                    oc.x = cvtpk_s(vc[j][0] * rc * gC[j].x, vc[j][1] * rc * gC[j].y); oc.y = cvtpk_s(vc[j][2] * rc * gC[j].z, vc[j][3] * rc * gC[j].w);
                    *(v2u*)(yrow + 512 + hh * HD + ci) = ob; *(v2u*)(yrow + 1280 + hh * HD + ci) = oc; }
#pragma unroll
                for (int j = 0; j < 3; ++j) { a[j] = an[j]; b[j] = bn[j]; c[j] = cn[j]; e[j] = en[j]; s1[j] = s1n[j]; s2[j] = s2n[j]; s3[j] = s3n[j]; }
                wa = wan;
            }
#undef COMB_LOAD
        }
        SEAM(pb + P_COMB);
        if (IN(pb + P_WOUT)) { PHASE_IDS();
            pg8::Gemm g{YMIX, WOUT_T, M, D, D}; pg8::StaticOrder S; S.init(M, D, G, bid); pg8::EpiBf16<0> E{YBUF, D, nullptr};
            pg8::gemm_phase<pg8::EpiBf16<0>, pg8::StaticOrder, true, true>(L + RING_OFF, g, S, E, tid);
        }
        SEAM(pb + P_WOUT);
        if (IN(pb + P_ROW1)) { PHASE_IDS();
            rows_split<1>(nullptr, nullptr, XH, YBUF, args.in[5] + (size_t)l * D, RSTD, nullptr, gw, NGW, lane);
        }
        SEAM(pb + P_ROW1);
        if (IN(pb + P_MQ)) { PHASE_IDS();
            pg8::Gemm g{XH, WMQ_T, M, MEM_W, D}; pg8::StaticOrder S; S.init(M, MEM_W, G, bid); pg8::EpiBf16<0> E{QBUF, MEM_W, nullptr, nullptr};
            pg8::gemm_phase<pg8::EpiBf16<0>, pg8::StaticOrder, true, true>(L + RING_OFF, g, S, E, tid);
            if (G == 256 && bid >= 128) CONV_RANGE(N_EARLY + N_DEF_PROJ, NITEMS, (bid - 128) * NWAVES + wave, (256 - 128) * NWAVES);
        }
        SEAM(pb + P_MQ);
        if (IN(pb + P_XATT)) { PHASE_IDS();
            LAS unsigned char* wl = L + RING_OFF + wave * 16384;
            const int vcu = (G % 8 == 0) ? (bid % 8) * (G / 8) + bid / 8 : bid;
            MakeX mk{QBUF, MEMKV, OBUF};
            attn_stream<false, MakeX>(mk, vcu * NWAVES + wave, 4 * (M / 32), NGW, wl, lane);
        }
        SEAM(pb + P_XATT);
        if (IN(pb + P_MO)) { PHASE_IDS();
            pg8::Gemm g{OBUF, WMO_T, M, D, MEM_W}; pg8::StaticOrder S; S.init(M, D, G, bid); pg8::EpiBf16<0> E{YBUF, D, nullptr};
            pg8::gemm_phase<pg8::EpiBf16<0>, pg8::StaticOrder, true, true>(L + RING_OFF, g, S, E, tid);
        }
        SEAM(pb + P_MO);
        if (IN(pb + P_ROW2)) { PHASE_IDS();
            rows_split<1>(nullptr, nullptr, XH, YBUF, args.in[18] + (size_t)l * D, RSTD, nullptr, gw, NGW, lane);
        }
        SEAM(pb + P_ROW2);
        for (int c = 0; c < NFCH; ++c) {
            if (IN(pb + P_FF0 + 2 * c)) { PHASE_IDS();
                pg8::Gemm g{XH + (size_t)c * FCH * D, W1_T, FCH, DFF, D}; pg8::StaticOrder S; S.init(FCH, DFF, G, bid); pg8::EpiBf16<1> E{UBUF, DFF, nullptr, nullptr};
                pg8::gemm_phase<pg8::EpiBf16<1>, pg8::StaticOrder, true, true>(L + RING_OFF, g, S, E, tid);
            }
            SEAM(pb + P_FF0 + 2 * c);
            if (IN(pb + P_FF1 + 2 * c)) { PHASE_IDS();
                pg8::Gemm g{UBUF, W2_T, FCH, D, DFF}; pg8::StaticOrder S; S.init(FCH, D, G, bid); pg8::EpiBf16<0> E{YBUF + (size_t)c * FCH * D, D, nullptr};
                pg8::gemm_phase<pg8::EpiBf16<0>, pg8::StaticOrder, true, true>(L + RING_OFF, g, S, E, tid);
            }
            SEAM(pb + P_FF1 + 2 * c);
        }
        if (IN(pb + P_ROW3)) { PHASE_IDS();
            const bool nxt = (l + 1 < DEPTH);
            if (nxt) rows_split<1>(nullptr, nullptr, XH, YBUF, args.in[25] + (size_t)l * D, RSTD, nullptr, gw, NGW, lane);
            else rows_split<2>(nullptr, nullptr, XH, YBUF, args.in[25] + (size_t)l * D, RSTD, X, gw, NGW, lane);
        }
        SEAM(pb + P_ROW3);
    }
#undef IN
#undef SEAM
}

extern "C" void kernel_launch(void* const* d_in, const int* in_sizes, int n_in, void* d_out, int out_size, void* d_ws, size_t ws_size, hipStream_t stream) {
    static int grid = 0;
    if (grid == 0) {
        if (n_in != 28 || out_size != M * D || ws_size < WS_END) { fprintf(stderr, "kernel_launch: unexpected shapes (n_in %d out %d ws %zu)\n", n_in, out_size, ws_size); grid = -1; return; }
        int dev = 0, cus = 0, per_cu = 0;
        if (hipGetDevice(&dev) != hipSuccess || hipDeviceGetAttribute(&cus, hipDeviceAttributeMultiprocessorCount, dev) != hipSuccess) { grid = -1; return; }
        if (hipFuncSetAttribute((const void*)trunk_fwd, hipFuncAttributeMaxDynamicSharedMemorySize, LDS_BYTES) != hipSuccess) { grid = -1; return; }
        if (hipOccupancyMaxActiveBlocksPerMultiprocessor(&per_cu, (const void*)trunk_fwd, NWAVES * 64, LDS_BYTES) != hipSuccess || per_cu < 1) { fprintf(stderr, "kernel_launch: occupancy query says %d\n", per_cu); }
        (void)hipGetLastError();
        grid = cus;
    }
    if (grid < 0) return;
    (void)in_sizes;
    if (hipMemsetAsync((char*)d_ws + WS_CTL, 0, CTL_ZERO_BYTES, stream) != hipSuccess) return;
    Args a{};
    for (int i = 0; i < 28; ++i) a.in[i] = (const float*)d_in[i];
    a.out = (float*)d_out; a.ws = (unsigned char*)d_ws;
    a.ph_lo = 0; a.ph_hi = NPHASES; a.mask = (1 << NP) - 1; a.sync = 1;
    hipLaunchKernelGGL(trunk_fwd, dim3(grid), dim3(NWAVES * 64), LDS_BYTES, stream, a);
#if defined(PROBE_MASK)
    a.out = (float*)((unsigned char*)d_ws + WS_PROJ); a.ph_lo = PROBE_LAYER * NP; a.ph_hi = PROBE_LAYER * NP + NP; a.mask = PROBE_MASK; a.sync = 0;
    for (int r = 0; r < PROBE_REPS; ++r) hipLaunchKernelGGL(trunk_fwd, dim3(grid), dim3(NWAVES * 64), LDS_BYTES, stream, a);
#endif
}
```

```cpp
#include <hip/hip_runtime.h>
#include <cstdio>
#include <cstdint>
namespace pg8 {
#define PG8_LAS __attribute__((address_space(3)))
typedef unsigned short bf16_t;
typedef short bf16x8 __attribute__((ext_vector_type(8)));
typedef float f32x4 __attribute__((ext_vector_type(4)));
typedef unsigned u32x4 __attribute__((ext_vector_type(4)));
constexpr int BM = 256, BK = 64, HALF = 128, HTB = HALF * BK * 2  , STAGE_BYTES = 8 * HTB, NXCD = 8, WGM = 8;

__host__ __device__ __forceinline__ int lds_byte(int r, int c) { const int st = (r >> 4) * 2 + (c >> 5), rr = r & 15, cc = c & 31, ob = rr * 64 + cc * 2; return st * 1024 + (ob ^ (((ob >> 9) & 1) << 5)); }
__host__ __device__ __forceinline__ void stage_rc(int b, int& R, int& C) { const int st = b / 1024, sb = b % 1024, swz = sb ^ (((sb >> 9) & 1) << 5); R = (st >> 1) * 16 + swz / 64; C = (st & 1) * 32 + (swz % 64) / 2; }
__host__ __device__ __forceinline__ int perm32(int rho) { const int n = rho >> 4, i = rho & 15; return 8 * (i >> 2) + 4 * n + (i & 3); }

struct Unit { int pm, pn; };
struct Gemm { const bf16_t* A; const bf16_t* Bt; int M, N, K; };

struct StaticOrder {
    int nM, nN, nwg, G, c;
    __host__ __device__ void init(int M, int N, int G_, int c_) { nM = M / BM; nN = N / BM; nwg = nM * nN; G = G_; c = c_; }
    __host__ __device__ bool next(int i, Unit& u) const {
        const long L = (long)i * G + c; if (L >= nwg) return false;
        int wgid = (int)L; { const int q = nwg / NXCD, r = nwg % NXCD, xcd = wgid % NXCD, off = wgid / NXCD; wgid = (xcd < r ? xcd * (q + 1) : r * (q + 1) + (xcd - r) * q) + off; }
        const int nig = WGM * nN, gid = wgid / nig, fm = gid * WGM, gsz = (nM - fm) < WGM ? (nM - fm) : WGM;
        u.pm = fm + ((wgid % nig) % gsz); u.pn = (wgid % nig) / gsz; return true;
    }
    __device__ __forceinline__ void a_ready(const Unit&) const {}
    __device__ __forceinline__ void done(const Unit&) const {}
};

__device__ __forceinline__ unsigned cvt_pk_bf16(float lo, float hi) { unsigned r; asm volatile("v_cvt_pk_bf16_f32 %0, %1, %2" : "=v"(r) : "v"(lo), "v"(hi)); return r; }
template <int ACT  > struct EpiBf16 {
    static constexpr bool PERM = true, AFTER_DRAIN = false;
    bf16_t* O; int ldc; const float* bias; const float* rs;
    __device__ __forceinline__ void fused(f32x4 (&)[2][2][4][2], const Unit&, int, int, int, int, PG8_LAS unsigned char*, int, int) const {}
    __device__ __forceinline__ void operator()(const f32x4 (&acc)[2][2][4][2], const Unit& u, int wr, int wc, int fr, int fq) const {
        const int row0 = u.pm * BM + wr * 64 + fr; const int colt = u.pn * BM; bf16_t* base = O;
        const int col0 = colt + wc * 32 + 8 * fq;
        f32x4 bv[2][2];
#pragma unroll
        for (int bj = 0; bj < 2; ++bj)
#pragma unroll
            for (int n = 0; n < 2; ++n) bv[bj][n] = bias ? *(const f32x4*)(bias + col0 + bj * HALF + 4 * n) : (f32x4){0.f, 0.f, 0.f, 0.f};
#pragma unroll
        for (int ai = 0; ai < 2; ++ai)
#pragma unroll
            for (int m = 0; m < 4; ++m) { bf16_t* rowp = base + (size_t)(row0 + ai * HALF + m * 16) * ldc + col0; const float sc = rs ? rs[row0 + ai * HALF + m * 16] : 1.f;
#pragma unroll
                for (int bj = 0; bj < 2; ++bj) { f32x4 v0 = (acc[ai][bj][m][0] + bv[bj][0]) * sc, v1 = (acc[ai][bj][m][1] + bv[bj][1]) * sc;
                    if (ACT == 1) {
#pragma unroll
                        for (int j = 0; j < 4; ++j) { const float a = fmaxf(v0[j], 0.f), b = fmaxf(v1[j], 0.f); v0[j] = a * a; v1[j] = b * b; } }
                    u32x4 w; w.x = cvt_pk_bf16(v0[0], v0[1]); w.y = cvt_pk_bf16(v0[2], v0[3]); w.z = cvt_pk_bf16(v1[0], v1[1]); w.w = cvt_pk_bf16(v1[2], v1[3]);
                    *(u32x4*)(rowp + bj * HALF) = w; } }
    }
};

template <class Epi, class Sched, bool ALIGN_EPI = false, bool SP2 = false, int KS = 0>
__device__ __forceinline__ void gemm_phase(PG8_LAS unsigned char* lds, const Gemm g, const Sched& S, const Epi& E, const int tid_in) {
    int tid_ = tid_in; asm volatile("" : "+v"(tid_));
    const int tid = tid_, wid = __builtin_amdgcn_readfirstlane(tid >> 6), lane = tid & 63, wr = wid >> 2, wc = wid & 3, fr = lane & 15, fq = lane >> 4;
    const int K = g.K, KB = KS ? KS : K; int nt = KB / BK; if (KS) asm volatile("" : "+s"(nt));
    unsigned voffA[2], voffB[2];
#pragma unroll
    for (int i = 0; i < 2; ++i) { int R, C; stage_rc(tid * 16 + i * 8192, R, C); const int Rb = Epi::PERM ? ((R & ~31) + perm32(R & 31)) : R;
        voffA[i] = (unsigned)(R * K + C) * 2u; voffB[i] = (unsigned)(Rb * KB + C) * 2u; }
    const size_t kstep = (size_t)(BK * 2);
    const size_t hstep = (size_t)HALF * K * 2;
    const size_t tstep = 2 * hstep;
    const size_t hstepB = (size_t)HALF * KB * 2, tstepB = 2 * hstepB;
    const unsigned ldsw = (unsigned)wid * 1024u;
    const int aoff = lds_byte(wr * 64 + fr, fq * 8), boff = lds_byte(wc * 32 + fr, fq * 8);
#define PG8_SA(b, h) (((b) * 2 + (h)) * HTB)
#define PG8_SB(b, h) ((4 + (b) * 2 + (h)) * HTB)
#define PG8_STAGE(bufoff, gbase, voff) do { _Pragma("unroll") for (int _i = 0; _i < 2; ++_i) \
        __builtin_amdgcn_global_load_lds((const unsigned*)((const char*)(gbase) + (voff)[_i]), (PG8_LAS unsigned*)(lds + (bufoff) + ldsw + _i * 8192), 16, 0, 0); } while (0)
#define PG8_LDA(dst, b, h) do { _Pragma("unroll") for (int m = 0; m < 4; ++m) _Pragma("unroll") for (int k = 0; k < 2; ++k) dst[m][k] = *(const PG8_LAS bf16x8*)(lds + PG8_SA(b, h) + aoff + m * 2048 + k * 1024); } while (0)
#define PG8_LDB(dst, b, h) do { _Pragma("unroll") for (int n = 0; n < 2; ++n) _Pragma("unroll") for (int k = 0; k < 2; ++k) dst[n][k] = *(const PG8_LAS bf16x8*)(lds + PG8_SB(b, h) + boff + n * 2048 + k * 1024); } while (0)
#define PG8_MMA(ai, bj, At, Bt) do { __builtin_amdgcn_s_setprio(1); _Pragma("unroll") for (int m = 0; m < 4; ++m) _Pragma("unroll") for (int n = 0; n < 2; ++n) _Pragma("unroll") for (int k = 0; k < 2; ++k) \
        acc[ai][bj][m][n] = __builtin_amdgcn_mfma_f32_16x16x32_bf16(Bt[n][k], At[m][k], acc[ai][bj][m][n], 0, 0, 0); __builtin_amdgcn_s_setprio(0); } while (0)
#define PG8_WAIT_V(n) asm volatile("s_waitcnt vmcnt(" #n ")" ::: "memory")
#define PG8_WAIT_L(n) asm volatile("s_waitcnt lgkmcnt(" #n ")" ::: "memory")
#define PG8_BAR __builtin_amdgcn_s_barrier()
#define PG8_SCHED __builtin_amdgcn_sched_barrier(0)
    Unit cur, nxt; int ui = 0;
    if (!S.next(0, cur)) return;
    f32x4 acc[2][2][4][2];
#pragma unroll
    for (int a = 0; a < 2; ++a)
#pragma unroll
        for (int b = 0; b < 2; ++b)
#pragma unroll
            for (int m = 0; m < 4; ++m)
#pragma unroll
                for (int n = 0; n < 2; ++n) acc[a][b][m][n] = (f32x4){0.f, 0.f, 0.f, 0.f};
    bf16x8 At[4][2], B0[2][2], B1[2][2];
    const char* cA = (const char*)g.A + (size_t)cur.pm * tstep + (KS ? (size_t)(cur.pn >> 1) * (KS * 2) : 0); const char* cB = (const char*)g.Bt + (size_t)cur.pn * tstepB;
    S.a_ready(cur);
    if constexpr (SP2) {
        PG8_STAGE(PG8_SB(0, 0), cB, voffB); PG8_STAGE(PG8_SB(0, 1), cB + hstepB, voffB); PG8_STAGE(PG8_SA(0, 0), cA, voffA); PG8_STAGE(PG8_SA(0, 1), cA + hstep, voffA);
        if (wr == 1) PG8_BAR;
        PG8_WAIT_V(2); PG8_BAR;
        PG8_STAGE(PG8_SB(1, 0), cB + kstep, voffB); PG8_STAGE(PG8_SA(1, 0), cA + kstep, voffA); PG8_STAGE(PG8_SB(1, 1), cB + hstepB + kstep, voffB);
        PG8_WAIT_V(6); PG8_BAR;
    } else {
        PG8_STAGE(PG8_SB(0, 0), cB, voffB); PG8_STAGE(PG8_SA(0, 0), cA, voffA); PG8_STAGE(PG8_SB(0, 1), cB + hstepB, voffB); PG8_STAGE(PG8_SA(0, 1), cA + hstep, voffA);
        if (wr == 1) PG8_BAR;
        PG8_WAIT_V(4); PG8_BAR;
        PG8_STAGE(PG8_SB(1, 0), cB + kstep, voffB); PG8_STAGE(PG8_SA(1, 0), cA + kstep, voffA); PG8_STAGE(PG8_SB(1, 1), cB + hstepB + kstep, voffB);
        PG8_WAIT_V(6); PG8_BAR;
    }
    for (;;) {
        const bool has_next = S.next(ui + 1, nxt);
        const char* nA = has_next ? (const char*)g.A + (size_t)nxt.pm * tstep + (KS ? (size_t)(nxt.pn >> 1) * (KS * 2) : 0) : cA; const char* nB = has_next ? (const char*)g.Bt + (size_t)nxt.pn * tstepB : cB;
        asm volatile(".p2align 6\n .rept 12\n s_nop 0\n .endr" ::: "memory");
        for (int t = 0; t < nt; t += 2) {
            const bool last = (t == nt - 2);
            const char* a1 = cA + (size_t)(t + 1) * kstep;
            const char* a2 = last ? nA : cA + (size_t)(t + 2) * kstep; const char* b2 = last ? nB : cB + (size_t)(t + 2) * kstep;
            const char* a3 = a2 + kstep; const char* b3 = b2 + kstep;
            if (last && has_next) S.a_ready(nxt);
            if constexpr (SP2) {
            PG8_LDB(B0, 0, 0); PG8_LDB(B1, 0, 1); PG8_SCHED; PG8_LDA(At, 0, 0); PG8_STAGE(PG8_SA(1, 1), a1 + hstep, voffA);
            PG8_WAIT_V(8); PG8_WAIT_L(0); PG8_BAR; PG8_MMA(0, 0, At, B0); PG8_MMA(0, 1, At, B1); PG8_BAR; PG8_SCHED;
            PG8_LDA(At, 0, 1); PG8_STAGE(PG8_SB(0, 0), b2, voffB); PG8_STAGE(PG8_SB(0, 1), b2 + hstepB, voffB); PG8_STAGE(PG8_SA(0, 0), a2, voffA);
            PG8_WAIT_V(8); PG8_WAIT_L(0); PG8_BAR; PG8_MMA(1, 0, At, B0); PG8_MMA(1, 1, At, B1); PG8_BAR; PG8_SCHED;
            PG8_LDB(B0, 1, 0); PG8_LDB(B1, 1, 1); PG8_SCHED; PG8_LDA(At, 1, 0); PG8_STAGE(PG8_SA(0, 1), a2 + hstep, voffA);
            PG8_WAIT_V(8); PG8_WAIT_L(0); PG8_BAR; PG8_MMA(0, 0, At, B0); PG8_MMA(0, 1, At, B1); PG8_BAR; PG8_SCHED;
            PG8_LDA(At, 1, 1); PG8_STAGE(PG8_SB(1, 0), b3, voffB); PG8_STAGE(PG8_SB(1, 1), b3 + hstepB, voffB); PG8_STAGE(PG8_SA(1, 0), a3, voffA);
            PG8_WAIT_V(8); PG8_WAIT_L(0); PG8_BAR; PG8_MMA(1, 0, At, B0); PG8_MMA(1, 1, At, B1); PG8_BAR; PG8_SCHED;
            } else {
            PG8_LDB(B0, 0, 0); PG8_SCHED; PG8_LDA(At, 0, 0); PG8_STAGE(PG8_SA(1, 1), a1 + hstep, voffA);
            PG8_WAIT_L(8); PG8_BAR; PG8_WAIT_L(0); PG8_MMA(0, 0, At, B0); PG8_BAR; PG8_SCHED;
            PG8_LDB(B1, 0, 1); PG8_STAGE(PG8_SB(0, 0), b2, voffB);
            PG8_BAR; PG8_WAIT_L(0); PG8_MMA(0, 1, At, B1); PG8_BAR;
            PG8_LDA(At, 0, 1); PG8_STAGE(PG8_SA(0, 0), a2, voffA);
            PG8_BAR; PG8_WAIT_L(0); PG8_MMA(1, 0, At, B0); PG8_BAR; PG8_SCHED;
            PG8_STAGE(PG8_SB(0, 1), b2 + hstepB, voffB);
            PG8_WAIT_V(6); PG8_BAR; PG8_MMA(1, 1, At, B1); PG8_BAR;
            PG8_LDB(B0, 1, 0); PG8_SCHED; PG8_LDA(At, 1, 0); PG8_STAGE(PG8_SA(0, 1), a2 + hstep, voffA);
            PG8_WAIT_L(8); PG8_BAR; PG8_WAIT_L(0); PG8_MMA(0, 0, At, B0); PG8_BAR; PG8_SCHED;
            PG8_LDB(B1, 1, 1); PG8_STAGE(PG8_SB(1, 0), b3, voffB);
            PG8_BAR; PG8_WAIT_L(0); PG8_MMA(0, 1, At, B1); PG8_BAR;
            PG8_LDA(At, 1, 1); PG8_STAGE(PG8_SA(1, 0), a3, voffA);
            PG8_BAR; PG8_WAIT_L(0); PG8_MMA(1, 0, At, B0); PG8_BAR; PG8_SCHED;
            PG8_STAGE(PG8_SB(1, 1), b3 + hstepB, voffB);
            PG8_WAIT_V(6); PG8_BAR; PG8_MMA(1, 1, At, B1); PG8_BAR;
            }
        }
        if constexpr (ALIGN_EPI) { if (wr == 0) PG8_BAR; }
        if constexpr (!Epi::AFTER_DRAIN) { E(acc, cur, wr, wc, fr, fq); S.done(cur); }
        if (!has_next) break;
#pragma unroll
        for (int a = 0; a < 2; ++a)
#pragma unroll
            for (int b = 0; b < 2; ++b)
#pragma unroll
                for (int m = 0; m < 4; ++m)
#pragma unroll
                    for (int n = 0; n < 2; ++n) acc[a][b][m][n] = (f32x4){0.f, 0.f, 0.f, 0.f};
        cur = nxt; cA = nA; cB = nB; ++ui;
        if constexpr (ALIGN_EPI) { if (wr == 1) PG8_BAR; }
    }
    PG8_WAIT_V(0);
    if constexpr (!ALIGN_EPI) { if (wr == 0) PG8_BAR; }
    PG8_BAR;
    if constexpr (Epi::AFTER_DRAIN) { E.fused(acc, cur, wr, wc, fr, fq, lds, wid, lane); S.done(cur); }
#undef PG8_SA
#undef PG8_SB
#undef PG8_STAGE
#undef PG8_LDA
#undef PG8_LDB
#undef PG8_MMA
#undef PG8_WAIT_V
#undef PG8_WAIT_L
#undef PG8_BAR
#undef PG8_SCHED
}
}

constexpr int NWAVES = 8;
#ifndef MK_PER_PHASE
#define MK_PER_PHASE 0
#endif
constexpr int D = 2048, DEPTH = 4, SEQ_P = 4096, NB_P = 8, SEQ_S = 16384;
constexpr int MP = NB_P * SEQ_P;
constexpr int M = MP + SEQ_S;
constexpr int HD = 128, LRU_W = 512, IN_W = 4608;
constexpr float QSCALE2 = 0.08838834764831845f * 1.4426950408889634f;
constexpr int C_XA = 0, C_GATE = 512, C_QB = 1024, C_KB = 1792, C_VB = 2560, C_QC = 3328, C_KC = 4096, C_VC = 4352;
constexpr int PA_W = 1024, NHB = 28;
constexpr int NMEM = 256, MEM_W = 512, NSEQ = 9, MMEM = NSEQ * NMEM;
constexpr int DFF = 8192, FCH = 8192, NFCH = 6;
constexpr float EPS = 1e-6f;
constexpr int LCH = 32, NCHK = M / LCH;
enum { P_CONV = 0, P_PROJ, P_XC, P_GATES, P_AGG, P_CARRY, P_LRU, P_ATT, P_COMB, P_WOUT, P_ROW1, P_MQ, P_XATT, P_MO, P_ROW2, P_FF0, P_FF1, P_ROW3 = P_FF0 + 2 * 6, NP };
constexpr int NPHASES = NP * DEPTH;

constexpr size_t MiB = 1u << 20;
constexpr size_t WS_CTL = 0, CTL_ZERO_BYTES = 1 * MiB;
constexpr size_t WS_WIN = 2 * MiB, WS_WOUT = 20 * MiB, WS_WMQ = 28 * MiB, WS_WMKV = 30 * MiB, WS_WMO = 34 * MiB, WS_WG = 36 * MiB, WS_W1 = 38 * MiB, WS_W2 = 70 * MiB;
constexpr size_t WS_MEMN = 102 * MiB, WS_MEMKV = 111 * MiB, WS_AGG = 116 * MiB, WS_GBIAS = 122 * MiB;
constexpr size_t WS_XH = 124 * MiB, WS_XL = 316 * MiB, WS_YBUF = 508 * MiB, WS_PROJ = 700 * MiB, WS_AGG2 = 1132 * MiB, WS_CAR = 1148 * MiB, WS_RSTD = 1156 * MiB, WS_END = 1157 * MiB;
constexpr size_t OUT_XC = 0, OUT_YMIX = 48 * MiB;
static_assert(OUT_YMIX + (size_t)M * D * 2 <= (size_t)M * D * 4, "d_out scratch map");
constexpr size_t WS_U = WS_PROJ, WS_Q = WS_PROJ + 256 * MiB, WS_O = WS_PROJ + 304 * MiB;
static_assert(WS_PROJ + (size_t)M * IN_W * 2 <= WS_AGG2 && WS_O + (size_t)M * MEM_W * 2 <= WS_AGG2 && WS_U + (size_t)FCH * DFF * 2 <= WS_AGG2, "ws map");
constexpr int CW_BAR = 4096;

constexpr int RING_OFF = 0, RING_BYTES = 131072;
constexpr int LDSCTL_OFF = 8 * 16640, MISC_OFF = LDSCTL_OFF + 320;
constexpr int LDS_BYTES = 147456;

#define GAS __attribute__((address_space(1)))
#define LAS __attribute__((address_space(3)))
typedef unsigned short bf16;
typedef unsigned v4u __attribute__((ext_vector_type(4)));
typedef unsigned v2u __attribute__((ext_vector_type(2)));
typedef float f32x4 __attribute__((ext_vector_type(4)));
typedef GAS unsigned gu32;
typedef unsigned u32x4_t __attribute__((ext_vector_type(4)));
#define RLX_AGENT __ATOMIC_RELAXED, __HIP_MEMORY_SCOPE_AGENT
#define LDS_WAIT() asm volatile("s_waitcnt lgkmcnt(0)" ::: "memory")
#define VM_WAIT() asm volatile("s_waitcnt vmcnt(0)" ::: "memory")
__device__ __forceinline__ unsigned f2bf(float f) { unsigned u = __builtin_bit_cast(unsigned, f); return (u + 0x7fffu + ((u >> 16) & 1u)) >> 16; }
__device__ __forceinline__ unsigned pk2(float lo, float hi) { return f2bf(lo) | (f2bf(hi) << 16); }
typedef float f32x2_t __attribute__((ext_vector_type(2)));
typedef __bf16 bf16x2_t __attribute__((ext_vector_type(2)));
__device__ __forceinline__ unsigned cvtpk_s(float lo, float hi) { f32x2_t v = {lo, hi}; bf16x2_t b = __builtin_convertvector(v, bf16x2_t); return __builtin_bit_cast(unsigned, b); }
__device__ __forceinline__ float bflo(unsigned u) { return __uint_as_float(u << 16); }
__device__ __forceinline__ float bfhi(unsigned u) { return __uint_as_float(u & 0xffff0000u); }
__device__ __forceinline__ float bf1(bf16 b) { return __uint_as_float(((unsigned)b) << 16); }

#define XB_TMO      128
#define XB_XCNT(j)  (256  + 64 * (j))
#define XB_XSUB(j)  (1280 + 64 * (j))
#define XB_XGEN(j)  (2304 + 64 * (j))
#define XB_TOP      3328
#define XB_TOPGEN   3392
#define XCD_BAR_WORDS 3456
#define XB_SPIN_CAP (1u << 18)

__device__ __forceinline__ unsigned xb_ld(unsigned* p)              { return __hip_atomic_load(p, __ATOMIC_RELAXED, __HIP_MEMORY_SCOPE_AGENT); }
__device__ __forceinline__ unsigned xb_add(unsigned* p, unsigned v) { return __hip_atomic_fetch_add(p, v, __ATOMIC_RELAXED, __HIP_MEMORY_SCOPE_AGENT); }
__device__ __forceinline__ unsigned xb_xcc_id() { return (unsigned)__builtin_amdgcn_s_getreg((3 << 11) | 20) & 0xFu; }
#define XB_SPIN(cond, bar) do { unsigned _sp = 0; while (cond) { __builtin_amdgcn_s_sleep(1); \
    if ((++_sp & 255u) == 0u) { if (xb_ld(&(bar)[XB_TMO])) break; if (_sp > XB_SPIN_CAP) { atomicAdd(&(bar)[XB_TMO], 1u); break; } } } } while (0)

struct XcdBarrier {
    unsigned* bar; unsigned x;
    volatile LAS unsigned* st;
};

__device__ __forceinline__ XcdBarrier xcd_barrier_post(unsigned* bar, volatile LAS unsigned* st) {
    XcdBarrier b; b.bar = bar; b.x = xb_xcc_id(); b.st = st;
    if (threadIdx.x == 0) (void)xb_add(&bar[XB_XCNT(b.x)], 1u);
    return b;
}
__device__ __forceinline__ void xcd_barrier_complete(unsigned* bar, unsigned x, unsigned& nloc, unsigned& nx) {
    const unsigned G = gridDim.x * gridDim.y * gridDim.z;
    unsigned sum, cnt, mine, sp = 0u;
    for (;;) {
        sum = 0u; cnt = 0u; mine = 0u;
#pragma unroll
        for (unsigned j = 0; j < 16; ++j) { const unsigned c = xb_ld(&bar[XB_XCNT(j)]); sum += c; cnt += (c > 0u) ? 1u : 0u; mine = (j == x) ? c : mine; }
        if (sum == G) break;
        __builtin_amdgcn_s_sleep(1);
        if ((++sp & 255u) == 0u) { if (xb_ld(&bar[XB_TMO])) break; if (sp > XB_SPIN_CAP) { atomicAdd(&bar[XB_TMO], 1u); break; } }
    }
    nloc = mine > 0u ? mine : 1u; nx = cnt > 0u ? cnt : 1u;
}

__device__ __forceinline__ void xcd_barrier(const XcdBarrier& b) {
    asm volatile("s_waitcnt vmcnt(0)" ::: "memory");
    __syncthreads();
    if (threadIdx.x == 0) {
        unsigned* bar = b.bar;
        __builtin_amdgcn_s_waitcnt(0);
        unsigned nloc = b.st[0], nx = b.st[1];
        if (nloc == 0u) { xcd_barrier_complete(bar, b.x, nloc, nx); b.st[0] = nloc; b.st[1] = nx; }
        const unsigned old = xb_add(&bar[XB_XSUB(b.x)], 1u);
        const unsigned gen = old / nloc;
        if (old + 1u == (gen + 1u) * nloc) {
            __builtin_amdgcn_fence(__ATOMIC_RELEASE, "agent");
            asm volatile("s_waitcnt vmcnt(0)" ::: "memory");
            const unsigned og = xb_add(&bar[XB_TOP], 1u);
            const unsigned tg = og / nx;
            if (og + 1u == (tg + 1u) * nx) xb_add(&bar[XB_TOPGEN], 1u);
            else XB_SPIN(xb_ld(&bar[XB_TOPGEN]) == tg, bar);
            __builtin_amdgcn_fence(__ATOMIC_ACQUIRE, "agent");
            xb_add(&bar[XB_XGEN(b.x)], 1u);
            asm volatile("s_waitcnt vmcnt(0)" ::: "memory");
        } else {
            XB_SPIN(xb_ld(&bar[XB_XGEN(b.x)]) == gen, bar);
            __builtin_amdgcn_fence(__ATOMIC_ACQUIRE, "agent");
            asm volatile("s_waitcnt vmcnt(0)" ::: "memory");
        }
    }
    __syncthreads();
}


__device__ __forceinline__ float wave_sum_fast(float v) {
#define DPPF(x, ctrl) __builtin_bit_cast(float, __builtin_amdgcn_update_dpp(0, __builtin_bit_cast(int, x), ctrl, 0xf, 0xf, false))
    v += DPPF(v, 0x128); v += DPPF(v, 0x124); v += DPPF(v, 0x122); v += DPPF(v, 0x121);
#undef DPPF
    const int iv = __builtin_bit_cast(int, v);
    return (__builtin_bit_cast(float, __builtin_amdgcn_readlane(iv, 0)) + __builtin_bit_cast(float, __builtin_amdgcn_readlane(iv, 16))) +
           (__builtin_bit_cast(float, __builtin_amdgcn_readlane(iv, 32)) + __builtin_bit_cast(float, __builtin_amdgcn_readlane(iv, 48)));
}
__device__ __forceinline__ float fsig(float x) { return __builtin_amdgcn_rcpf(1.f + __builtin_amdgcn_exp2f(-1.4426950408889634f * x)); }
__device__ __forceinline__ float fgelu(float x) { return x * fsig(1.5957691216057308f * (x + 0.044715f * x * x * x)); }
__device__ __forceinline__ void lru_au(float gr, float gi, float xv, float sp2, float& a, float& u) {
    const float r = fsig(gr), ig = fsig(gi); a = __builtin_amdgcn_exp2f(-r * sp2); u = __builtin_amdgcn_sqrtf(fmaxf(1.f - a * a, 0.f)) * (ig * xv); }
__device__ __forceinline__ void lru_lu(float gr, float gi, float xv, float sp2, float& la, float& u) {
    const float r = fsig(gr), ig = fsig(gi); la = -r * sp2; const float a = __builtin_amdgcn_exp2f(la); u = __builtin_amdgcn_sqrtf(fmaxf(1.f - a * a, 0.f)) * (ig * xv); }
struct EpiProj {
    static constexpr bool PERM = true, AFTER_DRAIN = false; static constexpr int NSTORES = 16;
    bf16* PA; bf16* HB;
    __device__ __forceinline__ void operator()(const pg8::f32x4 (&acc)[2][2][4][2], const pg8::Unit& u, int wr, int wc, int fr, int fq) const {
        const int row0 = u.pm * 256 + wr * 64 + fr, colt = u.pn * 256, cw = wc * 32 + 8 * fq;
#pragma unroll
        for (int bj = 0; bj < 2; ++bj) {
            const int cb = colt + bj * 128;
            bf16* base; size_t ld;
            if (cb < PA_W) { base = PA + cb + cw; ld = PA_W; } else { base = HB + (size_t)((cb - PA_W) >> 7) * M * HD + cw; ld = HD; }
#pragma unroll
            for (int ai = 0; ai < 2; ++ai)
#pragma unroll
                for (int m = 0; m < 4; ++m) { const pg8::f32x4 v0 = acc[ai][bj][m][0], v1 = acc[ai][bj][m][1];
                    v4u w; w.x = cvtpk_s(v0[0], v0[1]); w.y = cvtpk_s(v0[2], v0[3]); w.z = cvtpk_s(v1[0], v1[1]); w.w = cvtpk_s(v1[2], v1[3]);
                    *(v4u*)(base + (size_t)(row0 + ai * 128 + m * 16) * ld) = w; }
        }
    }
};
struct EpiLU {
    static constexpr bool PERM = true, AFTER_DRAIN = false; static constexpr int NSTORES = 16;
    bf16* LU; const bf16* XC; const float* bias; const float* lam;
    __device__ __forceinline__ void operator()(const pg8::f32x4 (&acc)[2][2][4][2], const pg8::Unit& u, int wr, int wc, int fr, int fq) const {
        const int row0 = u.pm * 256 + wr * 64 + fr, col0 = u.pn * 256 + wc * 32 + 8 * fq;
#pragma unroll
        for (int bj = 0; bj < 2; ++bj) {
            const int col = col0 + bj * 128, c0 = col >> 2;
            const f32x4 b0 = *(const f32x4*)(bias + col), b1 = *(const f32x4*)(bias + col + 4);
            float sp[2][2];
#pragma unroll
            for (int dr = 0; dr < 2; ++dr)
#pragma unroll
                for (int e = 0; e < 2; ++e) sp[dr][e] = 8.f * __builtin_amdgcn_logf(1.f + __builtin_amdgcn_exp2f(-1.4426950408889634f * lam[dr * 512 + c0 + e]));
#pragma unroll
            for (int ai = 0; ai < 2; ++ai)
#pragma unroll
                for (int m = 0; m < 4; ++m) { const size_t r = (size_t)(row0 + ai * 128 + m * 16);
                    const unsigned xw = *(const unsigned*)(XC + r * LRU_W + c0);
                    const f32x4 g0 = acc[ai][bj][m][0] + b0, g1 = acc[ai][bj][m][1] + b1;
                    float laf0, lab0, laf1, lab1, uf0, ub0, uf1, ub1;
                    lru_lu(g0.x, g0.y, bflo(xw), sp[0][0], laf0, uf0); lru_lu(g0.z, g0.w, bflo(xw), sp[1][0], lab0, ub0);
                    lru_lu(g1.x, g1.y, bfhi(xw), sp[0][1], laf1, uf1); lru_lu(g1.z, g1.w, bfhi(xw), sp[1][1], lab1, ub1);
                    v4u o; o.x = cvtpk_s(laf0, uf0); o.y = cvtpk_s(lab0, ub0); o.z = cvtpk_s(laf1, uf1); o.w = cvtpk_s(lab1, ub1);
                    *(v4u*)(LU + (r * LRU_W + c0) * 4) = o; }
        }
    }
};
__device__ __forceinline__ int seq_start_row(int m) { return m < MP ? (m & ~(SEQ_P - 1)) : MP; }
__device__ __forceinline__ int seq_end_row(int m) { return m < MP ? (m & ~(SEQ_P - 1)) + SEQ_P : M; }

__device__ __forceinline__ void transpose_item(const float* W, int K, int N, bf16* WT, int row_off, LAS float* scr, int item, int lane) {
    const int nblk = N / 32, kb = item / nblk, nb = item % nblk, k0 = 64 * kb, n0 = 32 * nb;
#pragma unroll 8
    for (int i = 0; i < 32; ++i) { const int kk = 2 * i + (lane >> 5); scr[kk * 33 + (lane & 31)] = W[(size_t)(k0 + kk) * N + n0 + (lane & 31)]; }
    LDS_WAIT(); asm volatile("" ::: "memory");
    const int c = lane & 7;
#pragma unroll
    for (int j = 0; j < 4; ++j) { const int n = (lane >> 3) + 8 * j; const LAS float* s = scr + (8 * c) * 33 + n;
        v4u o; o.x = pk2(s[0 * 33], s[1 * 33]); o.y = pk2(s[2 * 33], s[3 * 33]); o.z = pk2(s[4 * 33], s[5 * 33]); o.w = pk2(s[6 * 33], s[7 * 33]);
        *(GAS v4u*)(WT + (size_t)(row_off + n0 + n) * K + k0 + 8 * c) = o; }
    LDS_WAIT(); asm volatile("" ::: "memory");
}

struct TItem { const float* W; bf16* WT; int K, N, row_off, k0, n0; const float* gk; float cs; };
__device__ __forceinline__ void titem_load(const TItem& t, int lane, f32x4 (&v)[16]) {
    const float* p = t.W + (size_t)(t.k0 + (lane >> 4)) * t.N + t.n0 + 4 * (lane & 15);
#pragma unroll
    for (int i = 0; i < 16; ++i) v[i] = __builtin_nontemporal_load((const f32x4*)(p + (size_t)(4 * i) * t.N));
}
__device__ __forceinline__ void titem_store(const TItem& t, int lane, const f32x4 (&v)[16], LAS float* scr) {
    const int r4 = lane >> 4, c4 = lane & 15;
#pragma unroll
    for (int i = 0; i < 16; ++i) { LAS float* s = scr + (4 * c4) * 65 + 4 * i + r4; const float g = (t.gk ? t.gk[t.k0 + 4 * i + r4] : 1.f) * t.cs; s[0] = v[i].x * g; s[65] = v[i].y * g; s[130] = v[i].z * g; s[195] = v[i].w * g; }
    LDS_WAIT(); asm volatile("" ::: "memory");
    const int nn = lane >> 3, c = lane & 7;
#pragma unroll
    for (int j = 0; j < 8; ++j) { const int n = nn + 8 * j; const LAS float* s = scr + n * 65 + 8 * c;
        v4u o; o.x = cvtpk_s(s[0], s[1]); o.y = cvtpk_s(s[2], s[3]); o.z = cvtpk_s(s[4], s[5]); o.w = cvtpk_s(s[6], s[7]);
        *(v4u*)(t.WT + (size_t)(t.row_off + t.n0 + n) * t.K + t.k0 + 8 * c) = o; if (j & 1) asm volatile("" ::: "memory"); }
    LDS_WAIT(); asm volatile("" ::: "memory");
}
__device__ __forceinline__ void row_pass(const float* xin, const bf16* yrow, const float* gpost, float* xout, const float* gnext, bf16* hrow, int lane) {
    float x[32];
#pragma unroll
    for (int j = 0; j < 4; ++j) { const f32x4 a = *(const f32x4*)(xin + j * 512 + lane * 8), b = *(const f32x4*)(xin + j * 512 + lane * 8 + 4);
        x[8 * j + 0] = a.x; x[8 * j + 1] = a.y; x[8 * j + 2] = a.z; x[8 * j + 3] = a.w; x[8 * j + 4] = b.x; x[8 * j + 5] = b.y; x[8 * j + 6] = b.z; x[8 * j + 7] = b.w; }
    if (yrow) {
        float y[32]; float ss = 0.f;
#pragma unroll
        for (int j = 0; j < 4; ++j) { const v4u w = *(const v4u*)(yrow + j * 512 + lane * 8);
            y[8 * j + 0] = bflo(w.x); y[8 * j + 1] = bfhi(w.x); y[8 * j + 2] = bflo(w.y); y[8 * j + 3] = bfhi(w.y); y[8 * j + 4] = bflo(w.z); y[8 * j + 5] = bfhi(w.z); y[8 * j + 6] = bflo(w.w); y[8 * j + 7] = bfhi(w.w); }
#pragma unroll
        for (int i = 0; i < 32; ++i) ss += y[i] * y[i];
        const float rstd = rsqrtf(wave_sum_fast(ss) * (1.f / D) + EPS);
#pragma unroll
        for (int j = 0; j < 4; ++j) { const f32x4 ga = *(const f32x4*)(gpost + j * 512 + lane * 8), gb = *(const f32x4*)(gpost + j * 512 + lane * 8 + 4);
            x[8 * j + 0] += y[8 * j + 0] * rstd * ga.x; x[8 * j + 1] += y[8 * j + 1] * rstd * ga.y; x[8 * j + 2] += y[8 * j + 2] * rstd * ga.z; x[8 * j + 3] += y[8 * j + 3] * rstd * ga.w;
            x[8 * j + 4] += y[8 * j + 4] * rstd * gb.x; x[8 * j + 5] += y[8 * j + 5] * rstd * gb.y; x[8 * j + 6] += y[8 * j + 6] * rstd * gb.z; x[8 * j + 7] += y[8 * j + 7] * rstd * gb.w; }
    }
    if (xout) {
#pragma unroll
        for (int j = 0; j < 4; ++j) { *(f32x4*)(xout + j * 512 + lane * 8) = (f32x4){x[8 * j + 0], x[8 * j + 1], x[8 * j + 2], x[8 * j + 3]}; *(f32x4*)(xout + j * 512 + lane * 8 + 4) = (f32x4){x[8 * j + 4], x[8 * j + 5], x[8 * j + 6], x[8 * j + 7]}; }
    }
    if (hrow) {
        float ss = 0.f;
#pragma unroll
        for (int i = 0; i < 32; ++i) ss += x[i] * x[i];
        const float rstd = rsqrtf(wave_sum_fast(ss) * (1.f / D) + EPS);
#pragma unroll
        for (int j = 0; j < 4; ++j) { const f32x4 ga = *(const f32x4*)(gnext + j * 512 + lane * 8), gb = *(const f32x4*)(gnext + j * 512 + lane * 8 + 4);
            v4u o; o.x = pk2(x[8 * j + 0] * rstd * ga.x, x[8 * j + 1] * rstd * ga.y); o.y = pk2(x[8 * j + 2] * rstd * ga.z, x[8 * j + 3] * rstd * ga.w);
            o.z = pk2(x[8 * j + 4] * rstd * gb.x, x[8 * j + 5] * rstd * gb.y); o.w = pk2(x[8 * j + 6] * rstd * gb.z, x[8 * j + 7] * rstd * gb.w);
            *(v4u*)(hrow + j * 512 + lane * 8) = o; }
    }
}

typedef short bf16x8 __attribute__((ext_vector_type(8)));
typedef short s16x4 __attribute__((ext_vector_type(4)));
#ifndef ATT_DMA
#define ATT_DMA 0
#endif
struct ATask { const GAS bf16* Q; unsigned qst; const GAS bf16* K; const GAS bf16* V; unsigned kst; int jq0, jk0, nkeys, w, tlo, thi; float sd;
               bf16* O0; unsigned ost; float sink2; int has_sink; float* st; unsigned sst; };
__device__ __forceinline__ unsigned off_b(unsigned row, unsigned ch) { return 256u * row + 16u * (ch ^ (((row & 3) << 2) | ((row >> 2) & 3))); }
__device__ __forceinline__ float rows_max(float v) {
    auto a = __builtin_amdgcn_permlane16_swap(__float_as_uint(v), __float_as_uint(v), false, false); v = __builtin_fmaxf(__uint_as_float(a[0]), __uint_as_float(a[1]));
    auto b = __builtin_amdgcn_permlane32_swap(__float_as_uint(v), __float_as_uint(v), false, false); return __builtin_fmaxf(__uint_as_float(b[0]), __uint_as_float(b[1])); }
__device__ __forceinline__ float rows_sum(float v) {
    auto a = __builtin_amdgcn_permlane16_swap(__float_as_uint(v), __float_as_uint(v), false, false); v = __uint_as_float(a[0]) + __uint_as_float(a[1]);
    auto b = __builtin_amdgcn_permlane32_swap(__float_as_uint(v), __float_as_uint(v), false, false); return __uint_as_float(b[0]) + __uint_as_float(b[1]); }
struct MakeAtt { bf16* HB; bf16* YMIX; bf16* OP23; float* STATS; const float* sink;
    __device__ __forceinline__ void operator()(int id, ATask& T) const {
        const int ph = id / (M / 32), u = id % (M / 32);
        const bool dil = ph < 18;
        const int pi = dil ? ph / 6 : 0, hh = dil ? ph % 6 : ph - 18, dsh = !dil ? 0 : 2 * pi, d = 1 << dsh;
        const int gi = u >> dsh, r = u & (d - 1), g0 = gi * 32 * d, sb = seq_start_row(g0), n = (seq_end_row(g0) - sb) >> dsh;
        const int wband = dil ? 64 : 128, kvh = dil ? hh : hh / 3, nt = dil ? 5 : 9;
        const size_t row0 = (size_t)(g0 + r);
        T.Q = (const GAS bf16*)(HB + ((size_t)((dil ? 0 : 18) + hh) * M + row0) * HD); T.qst = (unsigned)d * HD;
        T.K = (const GAS bf16*)(HB + ((size_t)((dil ? 6 : 24) + kvh) * M + (size_t)(sb + r)) * HD); T.V = (const GAS bf16*)(HB + ((size_t)((dil ? 12 : 26) + kvh) * M + (size_t)(sb + r)) * HD); T.kst = (unsigned)d * HD;
        T.jq0 = (g0 - sb) >> dsh; T.jk0 = T.jq0 - wband; T.nkeys = n; T.w = wband;
        T.tlo = T.jk0 < 0 ? (-T.jk0) >> 5 : 0; T.thi = (T.jk0 + 32 * nt > n) ? (n - T.jk0) >> 5 : nt;
        T.sd = __builtin_amdgcn_exp2f(-8.f * (float)(hh + 1) / 6.f) * (float)d * 1.4426950408889634f;
        T.has_sink = dil ? 0 : 1; T.sink2 = dil ? 0.f : sink[hh] * 1.4426950408889634f;
        if (!dil) { T.O0 = YMIX + row0 * D + 1280 + hh * HD; T.ost = D; T.st = nullptr; T.sst = 0; }
        else { if (pi == 0) { T.O0 = YMIX + row0 * D + 512 + hh * HD; T.ost = D; } else { T.O0 = OP23 + (size_t)(pi - 1) * M * 768 + row0 * 768 + hh * HD; T.ost = (unsigned)d * 768; }
               T.st = STATS + ((row0 * 6 + hh) * 3 + pi) * 2; T.sst = (unsigned)d * 36; }
    }
};
struct MakeX { bf16* QBUF; bf16* MEMKV; bf16* OBUF;
    __device__ __forceinline__ void operator()(int id, ATask& T) const {
        const int hh = id / (M / 32), u = id % (M / 32), g0 = u * 32; const int b = g0 < MP ? (g0 >> 12) : NB_P;
        T.Q = (const GAS bf16*)(QBUF + (size_t)g0 * MEM_W + hh * HD); T.qst = MEM_W;
        T.K = (const GAS bf16*)(MEMKV + (size_t)b * NMEM * (2 * MEM_W) + hh * HD); T.V = T.K + MEM_W; T.kst = 2 * MEM_W;
        T.jq0 = 0; T.jk0 = 0; T.nkeys = NMEM; T.w = 0; T.tlo = 0; T.thi = NMEM / 32; T.sd = 0.f;
        T.O0 = OBUF + (size_t)g0 * MEM_W + hh * HD; T.ost = MEM_W; T.sink2 = 0.f; T.has_sink = 0; T.st = nullptr; T.sst = 0;
    }
};
template <bool BAND, class Maker>
__device__ __forceinline__ void attn_stream(const Maker& mk, int id0, int nid, int stride, LAS unsigned char* wl, int lane_in) {
    int id = id0; if (id >= nid) return;
    int lane = lane_in; asm volatile("" : "+v"(lane));
    const int fr = lane & 15, fq = lane >> 4, rr = lane >> 4, pc = lane & 15;
    const unsigned koff0_ = off_b(fr, fq), voff0_ = 8192u + off_b(4 * fq + (fr >> 2), (fr & 3) >> 1) + 8u * (fr & 1);
    const unsigned woff = off_b(rr, pc);
    ATask Tc, Tn; mk(id, Tc);
    bf16x8 qf[2][4]; v4u kreg[8], vreg[8];
#define ATT_UPTR(p) ((const GAS unsigned char*)(((unsigned long long)(unsigned)__builtin_amdgcn_readfirstlane((int)((unsigned long long)(p) >> 32)) << 32) | (unsigned long long)(unsigned)__builtin_amdgcn_readfirstlane((int)(unsigned)(unsigned long long)(p))))
#define ATT_ISSUE_Q(T_) do { const GAS unsigned char* q_ = ATT_UPTR((T_).Q); const unsigned qstb_ = (T_).qst * 2u, lq_ = (unsigned)fr * qstb_ + 16u * (unsigned)fq; \
        _Pragma("unroll") for (int qb = 0; qb < 2; ++qb) _Pragma("unroll") for (int s = 0; s < 4; ++s) \
        qf[qb][s] = *(const GAS bf16x8*)(q_ + (size_t)(16u * (unsigned)qb * qstb_ + 64u * (unsigned)s) + lq_); } while (0)
#define ATT_ISSUE(dst, T_, base, tt) do { const unsigned kstb_ = (T_).kst * 2u; const GAS unsigned char* p_ = ATT_UPTR((const GAS unsigned char*)(base) + (size_t)(unsigned)((T_).jk0 + 32 * (tt)) * kstb_); \
        const unsigned loff_ = ((unsigned)rr * (T_).kst + 8u * (unsigned)pc) * 2u; \
        _Pragma("unroll") for (int i = 0; i < 8; ++i) dst[i] = *(const GAS v4u*)(p_ + (size_t)(4u * (unsigned)i * kstb_) + loff_); } while (0)
    ATT_ISSUE_Q(Tc); ATT_ISSUE(kreg, Tc, Tc.K, Tc.tlo); ATT_ISSUE(vreg, Tc, Tc.V, Tc.tlo);
    for (;;) {
        const int idn = id + stride; const bool hn = idn < nid;
        if (hn) mk(idn, Tn); else Tn = Tc;
        f32x4 O[2][8]; float mrow[2], lrow[2];
#pragma unroll
        for (int qb = 0; qb < 2; ++qb) { mrow[qb] = -INFINITY; lrow[qb] = 0.f;
#pragma unroll
            for (int db = 0; db < 8; ++db) O[qb][db] = (f32x4){0.f, 0.f, 0.f, 0.f}; }
        asm volatile(".p2align 6" ::: "memory");
        for (int t = Tc.tlo; t < Tc.thi; ++t) {
            const bool last = (t + 1 == Tc.thi);
            unsigned koff0 = koff0_, voff0 = voff0_, wo = woff; asm volatile("" : "+v"(koff0), "+v"(voff0), "+v"(wo));
#pragma unroll
            for (int i = 0; i < 8; ++i) *(LAS v4u*)(wl + i * 1024 + (wo ^ (unsigned)((i & 3) << 4))) = kreg[i];
            if (!last) ATT_ISSUE(kreg, Tc, Tc.K, t + 1);
            asm volatile("s_waitcnt lgkmcnt(0)" ::: "memory");
            f32x4 S[2][2];
#pragma unroll
            for (int qb = 0; qb < 2; ++qb)
#pragma unroll
                for (int kb = 0; kb < 2; ++kb) S[qb][kb] = (f32x4){0.f, 0.f, 0.f, 0.f};
#pragma unroll
            for (int kb = 0; kb < 2; ++kb)
#pragma unroll
                for (int s = 0; s < 4; ++s) { const bf16x8 kf = *(const LAS bf16x8*)(wl + kb * 4096 + (koff0 ^ (unsigned)(s << 6)));
#pragma unroll
                    for (int qb = 0; qb < 2; ++qb) S[qb][kb] = __builtin_amdgcn_mfma_f32_16x16x32_bf16(kf, qf[qb][s], S[qb][kb], 0, 0, 0); }
            if (last && hn) { asm volatile("" : "+v"(S[0][0]), "+v"(S[0][1]), "+v"(S[1][0]), "+v"(S[1][1]));
                ATT_ISSUE_Q(Tn); ATT_ISSUE(kreg, Tn, Tn.K, Tn.tlo); }
            const int jt = Tc.jk0 + 32 * t;
            const bool interior = !BAND || (jt - (Tc.jq0 + 31) >= -Tc.w && jt + 31 - Tc.jq0 <= Tc.w);
            bf16x8 pb[2];
#pragma unroll
            for (int qb = 0; qb < 2; ++qb) {
                float v[8];
                const float fd0 = (float)(jt + 4 * fq - (Tc.jq0 + 16 * qb + fr));
                if (!BAND) {
#pragma unroll
                    for (int i = 0; i < 8; ++i) v[i] = S[qb][i >> 2][i & 3];
                } else if (interior) {
#pragma unroll
                    for (int i = 0; i < 8; ++i) { const float ad = __builtin_fabsf(fd0 + (float)(16 * (i >> 2) + (i & 3))); v[i] = S[qb][i >> 2][i & 3] - Tc.sd * ad; }
                } else {
#pragma unroll
                    for (int i = 0; i < 8; ++i) { const float ad = __builtin_fabsf(fd0 + (float)(16 * (i >> 2) + (i & 3)));
                        v[i] = (ad <= (float)Tc.w) ? S[qb][i >> 2][i & 3] - Tc.sd * ad : -INFINITY; }
                }
                float tm = __builtin_fmaxf(__builtin_fmaxf(__builtin_fmaxf(v[0], v[1]), __builtin_fmaxf(v[2], v[3])), __builtin_fmaxf(__builtin_fmaxf(v[4], v[5]), __builtin_fmaxf(v[6], v[7])));
                if (__builtin_amdgcn_ballot_w64(tm > mrow[qb] + 8.f) != 0ull) {
                    tm = rows_max(tm);
                    const float mn = __builtin_fmaxf(mrow[qb], tm), msn = (mn == -INFINITY) ? 0.f : mn;
                    const float alpha = __builtin_amdgcn_exp2f(mrow[qb] - msn);
                    lrow[qb] *= alpha; mrow[qb] = mn;
#pragma unroll
                    for (int db = 0; db < 8; ++db) O[qb][db] = O[qb][db] * alpha;
                }
                const float ms = (mrow[qb] == -INFINITY) ? 0.f : mrow[qb];
                float rs = 0.f;
#pragma unroll
                for (int i = 0; i < 8; ++i) { v[i] = __builtin_amdgcn_exp2f(v[i] - ms); rs += v[i]; }
                lrow[qb] += rs;
                u32x4_t pk; pk.x = cvtpk_s(v[0], v[1]); pk.y = cvtpk_s(v[2], v[3]); pk.z = cvtpk_s(v[4], v[5]); pk.w = cvtpk_s(v[6], v[7]);
                pb[qb] = __builtin_bit_cast(bf16x8, pk);
            }
#pragma unroll
            for (int i = 0; i < 8; ++i) *(LAS v4u*)(wl + 8192 + i * 1024 + (wo ^ (unsigned)((i & 3) << 4))) = vreg[i];
            if (!last) ATT_ISSUE(vreg, Tc, Tc.V, t + 1); else if (hn) ATT_ISSUE(vreg, Tn, Tn.V, Tn.tlo);
            asm volatile("s_waitcnt lgkmcnt(0)" ::: "memory");
#pragma unroll
            for (int db = 0; db < 8; ++db) {
                const unsigned vo = voff0 ^ (unsigned)(db << 5);
                const s16x4 lo = __builtin_bit_cast(s16x4, __builtin_amdgcn_ds_read_tr16_b64_v4i16((LAS s16x4*)(wl + vo)));
                const s16x4 hi = __builtin_bit_cast(s16x4, __builtin_amdgcn_ds_read_tr16_b64_v4i16((LAS s16x4*)(wl + 4096 + vo)));
                const bf16x8 vf = __builtin_shufflevector(lo, hi, 0, 1, 2, 3, 4, 5, 6, 7);
#pragma unroll
                for (int qb = 0; qb < 2; ++qb) O[qb][db] = __builtin_amdgcn_mfma_f32_16x16x32_bf16(vf, pb[qb], O[qb][db], 0, 0, 0);
            }
        }
#pragma unroll
        for (int qb = 0; qb < 2; ++qb) {
            const unsigned i = 16u * qb + (unsigned)fr;
            lrow[qb] = rows_sum(lrow[qb]);
            const float den = Tc.has_sink ? lrow[qb] + __builtin_amdgcn_exp2f(Tc.sink2 - mrow[qb]) : lrow[qb];
            const float inv = 1.f / den;
            bf16* orow = Tc.O0 + (size_t)(i * Tc.ost);
#pragma unroll
            for (int db = 0; db < 8; ++db) { v2u w; w.x = cvtpk_s(O[qb][db][0] * inv, O[qb][db][1] * inv); w.y = cvtpk_s(O[qb][db][2] * inv, O[qb][db][3] * inv);
                *(v2u*)(orow + 16 * db + 4 * fq) = w; }
            if (Tc.st && fq == 0) *(float2*)(Tc.st + (size_t)(i * Tc.sst)) = make_float2(mrow[qb], lrow[qb]);
        }
        if (!hn) break;
        Tc = Tn; id = idn;
    }
#undef ATT_ISSUE
#undef ATT_ISSUE_Q
#undef ATT_UPTR
}

template <int MODE>
__device__ __forceinline__ void rows_split(const float* xin_p, const float* xin_s, bf16* XH, const bf16* Y, const float* gpost, float* RSTD, float* OUT, int gw, int NGW, int lane) {
    f32x4 gp[8];
#pragma unroll
    for (int j = 0; j < 8; ++j) gp[j] = (MODE != 0) ? *(const f32x4*)(gpost + 256 * j + 4 * lane) : (f32x4){0.f, 0.f, 0.f, 0.f};
    f32x4 fa[8], fb[8], fc[8]; v2u ha[8], ya[8], hb[8], yb[8], hc[8], yc[8];
#define ROWS_LOAD(mm, F_, H_, Y_) do { if (MODE == 0) { const float* src_ = (mm) < MP ? xin_p + (size_t)(mm) * D : xin_s + (size_t)((mm) - MP) * D; \
            _Pragma("unroll") for (int j = 0; j < 8; ++j) F_[j] = __builtin_nontemporal_load((const f32x4*)(src_ + 256 * j + 4 * lane)); } \
        else { _Pragma("unroll") for (int j = 0; j < 8; ++j) { H_[j] = *(const v2u*)(XH + (size_t)(mm) * D + 256 * j + 4 * lane); \
            Y_[j] = __builtin_nontemporal_load((const v2u*)(Y + (size_t)(mm) * D + 256 * j + 4 * lane)); } } } while (0)
#pragma unroll
    for (int j = 0; j < 8; ++j) { fa[j] = fb[j] = fc[j] = (f32x4){0.f, 0.f, 0.f, 0.f}; ha[j] = hb[j] = hc[j] = (v2u){0u, 0u}; ya[j] = yb[j] = yc[j] = (v2u){0u, 0u}; }
    int m = gw; float inva = 0.f, invb = 0.f, invc = 0.f;
    if (m < M) { ROWS_LOAD(m, fa, ha, ya); if (MODE != 0) inva = RSTD[m]; }
    if (m + NGW < M) { ROWS_LOAD(m + NGW, fb, hb, yb); if (MODE != 0) invb = RSTD[m + NGW]; }
    for (; m < M; m += NGW) {
        const int mn = m + 2 * NGW;
        if (mn < M) { ROWS_LOAD(mn, fc, hc, yc); if (MODE != 0) invc = RSTD[mn]; }
        f32x4 x[8]; float s2 = 0.f;
        if (MODE == 0) {
#pragma unroll
            for (int j = 0; j < 8; ++j) x[j] = fa[j];
        } else {
            f32x4 y[8]; float ss = 0.f;
#pragma unroll
            for (int j = 0; j < 8; ++j) { y[j] = (f32x4){bflo(ya[j].x), bfhi(ya[j].x), bflo(ya[j].y), bfhi(ya[j].y)}; ss += (y[j].x * y[j].x + y[j].y * y[j].y) + (y[j].z * y[j].z + y[j].w * y[j].w); }
            const float rstd = rsqrtf(wave_sum_fast(ss) * (1.f / D) + EPS);
#pragma unroll
            for (int j = 0; j < 8; ++j) { const f32x4 xh = (f32x4){bflo(ha[j].x), bfhi(ha[j].x), bflo(ha[j].y), bfhi(ha[j].y)};
                x[j] = xh * inva + y[j] * rstd * gp[j]; }
        }
        if (MODE == 2) {
#pragma unroll
            for (int j = 0; j < 8; ++j) __builtin_nontemporal_store(x[j], (f32x4*)(OUT + (size_t)m * D + 256 * j + 4 * lane));
        } else {
#pragma unroll
            for (int j = 0; j < 8; ++j) s2 += (x[j].x * x[j].x + x[j].y * x[j].y) + (x[j].z * x[j].z + x[j].w * x[j].w);
            const float ms = wave_sum_fast(s2) * (1.f / D) + EPS, r2 = rsqrtf(ms), inv = 1.f / r2;
#pragma unroll
            for (int j = 0; j < 8; ++j) { const f32x4 xs = x[j] * r2;
                v2u h; h.x = cvtpk_s(xs.x, xs.y); h.y = cvtpk_s(xs.z, xs.w);
                *(v2u*)(XH + (size_t)m * D + 256 * j + 4 * lane) = h; }
            if (lane == 0) RSTD[m] = inv;
        }
#pragma unroll
        for (int j = 0; j < 8; ++j) { fa[j] = fb[j]; ha[j] = hb[j]; ya[j] = yb[j]; fb[j] = fc[j]; hb[j] = hc[j]; yb[j] = yc[j]; }
        inva = invb; invb = invc;
    }
#undef ROWS_LOAD
}

struct Args { const float* in[28]; float* out; unsigned char* ws; int ph_lo, ph_hi, mask, sync; };
static_assert(sizeof(Args) == 28 * 8 + 8 + 8 + 16, "Args has no padding");

__global__ void __launch_bounds__(NWAVES * 64, 2) trunk_fwd(Args args) {
    extern __shared__ __attribute__((aligned(16))) unsigned char lds[];
    LAS unsigned char* L = (LAS unsigned char*)lds;
    volatile LAS unsigned* MISC = (volatile LAS unsigned*)(L + MISC_OFF);
    const int tid0 = threadIdx.x;
    const int G0 = gridDim.x, bid0 = blockIdx.x, wave0 = __builtin_amdgcn_readfirstlane(tid0 >> 6);
    { gu32* ctl0 = (gu32*)(args.ws + WS_CTL); (void)ctl0; }
    for (int u = tid0; u < (LDS_BYTES - LDSCTL_OFF) / 4; u += NWAVES * 64) ((LAS unsigned*)(L + LDSCTL_OFF))[u] = 0u;
    __syncthreads();
    XcdBarrier bar; bar.bar = (unsigned*)((gu32*)(args.ws + WS_CTL) + CW_BAR); bar.x = 0; bar.st = nullptr;
    if (args.sync) bar = xcd_barrier_post((unsigned*)((gu32*)(args.ws + WS_CTL) + CW_BAR), MISC + 8);
    const int lo = args.ph_lo, hi = args.ph_hi;
    const int pmask = args.mask, psync = args.sync;
#define IN(k) (((pmask >> ((k) % NP)) & 1) && lo <= (k) && (k) < hi)
#define SEAM(k) do { if (psync && lo <= (k) && (k) + 1 < hi) xcd_barrier(bar); } while (0)

#pragma unroll 1
    for (int l = 0; l < DEPTH; ++l) {
        const int pb = l * NP;
        unsigned char* ws = args.ws; float* X = args.out;
        asm volatile("" : "+s"(ws), "+s"(X));
#define PHASE_IDS() unsigned ones_ = ~0u; int wave = wave0, G = G0, bid = bid0; asm volatile("" : "+s"(ones_), "+s"(wave), "+s"(G), "+s"(bid)); const int lane = (int)__builtin_amdgcn_mbcnt_hi(ones_, __builtin_amdgcn_mbcnt_lo(ones_, 0u)); const int tid = wave * 64 + lane; const int gw = bid * NWAVES + wave, NGW = G * NWAVES; (void)lane; (void)gw; (void)NGW; (void)tid
        const float* x_prompt = args.in[0]; const float* x_sample = args.in[1]; const float* mem_prompt = args.in[2]; const float* mem_sample = args.in[3];
        bf16* WIN_T = (bf16*)(ws + WS_WIN); bf16* WOUT_T = (bf16*)(ws + WS_WOUT); bf16* WMQ_T = (bf16*)(ws + WS_WMQ); bf16* WMKV_T = (bf16*)(ws + WS_WMKV);
        bf16* WMO_T = (bf16*)(ws + WS_WMO); bf16* WG_T = (bf16*)(ws + WS_WG); bf16* W1_T = (bf16*)(ws + WS_W1); bf16* W2_T = (bf16*)(ws + WS_W2);
        bf16* MEMN = (bf16*)(ws + WS_MEMN); bf16* MEMKV = (bf16*)(ws + WS_MEMKV); float* AGG = (float*)(ws + WS_AGG2); float* BAGG = (float*)(ws + WS_CAR); float* BC = (float*)(ws + WS_CAR + 5 * MiB); float* GBIAS = (float*)(ws + WS_GBIAS);
        bf16* XC = (bf16*)((unsigned char*)X + OUT_XC); bf16* XH = (bf16*)(ws + WS_XH); float* RSTD = (float*)(ws + WS_RSTD); bf16* YBUF = (bf16*)(ws + WS_YBUF); bf16* PA = (bf16*)(ws + WS_PROJ); bf16* HB = PA + (size_t)M * PA_W;
        bf16* UBUF = (bf16*)(ws + WS_U); bf16* QBUF = (bf16*)(ws + WS_Q); bf16* OBUF = (bf16*)(ws + WS_O);
        bf16* GATES = YBUF;
        bf16* YMIX = (bf16*)((unsigned char*)X + OUT_YMIX);
        constexpr int I_IN = (D / 64) * (IN_W / 64), I_OUT = (D / 64) * (D / 64), I_MQ = (D / 64) * (MEM_W / 64), I_MO = (MEM_W / 64) * (D / 64), I_1 = (D / 64) * (DFF / 64), I_2 = (DFF / 64) * (D / 64);
        constexpr int NITEMS = I_IN + I_OUT + 3 * I_MQ + I_MO + I_1 + I_2;
#define TDECODE(t, it_) do { int r_ = (it_); \
                if (r_ < I_IN) { t.W = w_in; t.WT = WIN_T; t.K = D; t.N = IN_W; t.row_off = 0; t.gk = args.in[4] + (size_t)l * D; } \
                else if ((r_ -= I_IN) < I_OUT) { t.W = w_out; t.WT = WOUT_T; t.K = D; t.N = D; t.row_off = 0; t.gk = nullptr; } \
                else if ((r_ -= I_OUT) < I_MQ) { t.W = w_mq; t.WT = WMQ_T; t.K = D; t.N = MEM_W; t.row_off = 0; t.gk = args.in[17] + (size_t)l * D; } \
                else if ((r_ -= I_MQ) < I_MQ) { t.W = w_mk; t.WT = WMKV_T; t.K = D; t.N = MEM_W; t.row_off = 0; t.gk = nullptr; } \
                else if ((r_ -= I_MQ) < I_MQ) { t.W = w_mv; t.WT = WMKV_T; t.K = D; t.N = MEM_W; t.row_off = MEM_W; t.gk = nullptr; } \
                else if ((r_ -= I_MQ) < I_MO) { t.W = w_mo; t.WT = WMO_T; t.K = MEM_W; t.N = D; t.row_off = 0; t.gk = nullptr; } \
                else if ((r_ -= I_MO) < I_1) { t.W = w_ff1; t.WT = W1_T; t.K = D; t.N = DFF; t.row_off = 0; t.gk = args.in[24] + (size_t)l * D; } \
                else { r_ -= I_1; t.W = w_ff2; t.WT = W2_T; t.K = DFF; t.N = D; t.row_off = 0; t.gk = nullptr; } \
                const int nblk_ = t.N / 64; t.k0 = 64 * (r_ / nblk_); t.n0 = 64 * (r_ % nblk_); \
                t.cs = ((t.WT == WIN_T && ((t.n0 >= C_QB && t.n0 < C_KB) || (t.n0 >= C_QC && t.n0 < C_KC))) || t.WT == WMQ_T) ? QSCALE2 : 1.f; } while (0)
        constexpr int N_EARLY = NITEMS - I_1 - I_2 - I_MO, N_DEF_PROJ = 3680;
#define CONV_RANGE(I0_, I1_, W0_, NW_) do { \
            const float* w_in = args.in[6] + (size_t)l * D * IN_W; const float* w_out = args.in[16] + (size_t)l * D * D; \
            const float* w_mq = args.in[20] + (size_t)l * D * MEM_W; const float* w_mk = args.in[21] + (size_t)l * D * MEM_W; const float* w_mv = args.in[22] + (size_t)l * D * MEM_W; \
            const float* w_mo = args.in[23] + (size_t)l * MEM_W * D; const float* w_ff1 = args.in[26] + (size_t)l * D * DFF; const float* w_ff2 = args.in[27] + (size_t)l * DFF * D; \
            LAS float* scr64 = (LAS float*)(L + wave * 16640); \
            for (int it = (I0_) + (W0_); it < (I1_); it += (NW_)) { TItem ta; f32x4 va[16]; TDECODE(ta, it); titem_load(ta, lane, va); titem_store(ta, lane, va, scr64); } } while (0)
        if (IN(pb + P_CONV)) { PHASE_IDS();
            LAS float* scr = (LAS float*)(L + RING_OFF + wave * 16384);
            CONV_RANGE(0, (G == 256) ? N_EARLY : NITEMS, gw, NGW);
            for (int i = bid * 512 + tid; i < 2048 * 16; i += G * 512) {
                const int row = i >> 4, k0 = (i & 15) * 8, gi = row & 3, cch = row >> 2, n = cch >> 7, e = cch & 127;
                const float* wsrc = ((gi & 1) ? args.in[11] : args.in[9]) + ((size_t)((l * 2 + (gi >> 1)) * 4 + n)) * 16384 + (size_t)k0 * 128 + e;
                v4u o; o.x = pk2(wsrc[0], wsrc[128]); o.y = pk2(wsrc[256], wsrc[384]); o.z = pk2(wsrc[512], wsrc[640]); o.w = pk2(wsrc[768], wsrc[896]);
                *(v4u*)(WG_T + (size_t)row * 128 + k0) = o;
            }
            for (int i = bid * 512 + tid; i < 2048; i += G * 512) { const int gi = i & 3, c = i >> 2;
                GBIAS[i] = ((gi & 1) ? args.in[12] : args.in[10])[(size_t)(l * 2 + (gi >> 1)) * 512 + c]; }
            for (int r = gw; r < MMEM; r += NGW) {
                const float* src = r < NB_P * NMEM ? mem_prompt + (size_t)r * D : mem_sample + (size_t)(r - NB_P * NMEM) * D;
                row_pass(src, nullptr, nullptr, nullptr, args.in[19] + (size_t)l * D, MEMN + (size_t)r * D, lane);
            }
            if (l == 0) rows_split<0>(x_prompt, x_sample, XH, nullptr, nullptr, RSTD, nullptr, gw, NGW, lane);
        }
        SEAM(pb + P_CONV);
        if (IN(pb + P_PROJ)) { PHASE_IDS();
            { pg8::Gemm g{XH, WIN_T, M, IN_W, D}; pg8::StaticOrder S; S.init(M, IN_W, G, bid); EpiProj E{PA, HB};
              pg8::gemm_phase<EpiProj, pg8::StaticOrder, true, true>(L + RING_OFF, g, S, E, tid); }
            { pg8::Gemm g{MEMN, WMKV_T, MMEM, 2 * MEM_W, D}; pg8::StaticOrder S; S.init(MMEM, 2 * MEM_W, G, (bid + 128) % G); pg8::EpiBf16<0> E{MEMKV, 2 * MEM_W, nullptr};
              pg8::gemm_phase<pg8::EpiBf16<0>, pg8::StaticOrder, true, true>(L + RING_OFF, g, S, E, tid); }
            if (G == 256 && bid >= 164) CONV_RANGE(N_EARLY, N_EARLY + N_DEF_PROJ, (bid - 164) * NWAVES + wave, (256 - 164) * NWAVES);
        }
        SEAM(pb + P_PROJ);
        if (IN(pb + P_XC)) { PHASE_IDS();
            const float* cw = args.in[7] + (size_t)l * 4 * LRU_W; const float* cb = args.in[8] + (size_t)l * LRU_W;
            for (int i = bid * 512 + tid; i < (M / 4) * 64; i += G * 512) {
                const int m0 = (i >> 6) * 4, c0 = (i & 63) * 8; const int s0 = seq_start_row(m0), s1 = seq_end_row(m0);
                v4u w[7];
#pragma unroll
                for (int j = 0; j < 7; ++j) { const int r = m0 + j - 2; w[j] = (r >= s0 && r < s1) ? *(const v4u*)(PA + (size_t)r * PA_W + C_XA + c0) : (v4u){0u, 0u, 0u, 0u}; }
                float cwv[4][8], cbv[8];
#pragma unroll
                for (int j = 0; j < 4; ++j) { const f32x4 a = *(const f32x4*)(cw + j * LRU_W + c0), b = *(const f32x4*)(cw + j * LRU_W + c0 + 4);
                    cwv[j][0] = a.x; cwv[j][1] = a.y; cwv[j][2] = a.z; cwv[j][3] = a.w; cwv[j][4] = b.x; cwv[j][5] = b.y; cwv[j][6] = b.z; cwv[j][7] = b.w; }
                { const f32x4 a = *(const f32x4*)(cb + c0), b = *(const f32x4*)(cb + c0 + 4); cbv[0] = a.x; cbv[1] = a.y; cbv[2] = a.z; cbv[3] = a.w; cbv[4] = b.x; cbv[5] = b.y; cbv[6] = b.z; cbv[7] = b.w; }
#pragma unroll
                for (int q = 0; q < 4; ++q) {
                    float acc[8];
#pragma unroll
                    for (int e = 0; e < 8; ++e) acc[e] = cbv[e];
#pragma unroll
                    for (int j = 0; j < 4; ++j) { const v4u ww = w[q + j];
                        acc[0] += cwv[j][0] * bflo(ww.x); acc[1] += cwv[j][1] * bfhi(ww.x); acc[2] += cwv[j][2] * bflo(ww.y); acc[3] += cwv[j][3] * bfhi(ww.y);
                        acc[4] += cwv[j][4] * bflo(ww.z); acc[5] += cwv[j][5] * bfhi(ww.z); acc[6] += cwv[j][6] * bflo(ww.w); acc[7] += cwv[j][7] * bfhi(ww.w); }
                    v4u o; o.x = cvtpk_s(acc[0], acc[1]); o.y = cvtpk_s(acc[2], acc[3]); o.z = cvtpk_s(acc[4], acc[5]); o.w = cvtpk_s(acc[6], acc[7]);
                    *(v4u*)(XC + (size_t)(m0 + q) * LRU_W + c0) = o;
                }
            }
        }
        SEAM(pb + P_XC);
        if (IN(pb + P_GATES)) { PHASE_IDS();
            pg8::Gemm g{XC, WG_T, M, 2048, LRU_W}; pg8::StaticOrder S; S.init(M, 2048, G, bid); EpiLU E{GATES, XC, GBIAS, args.in[13] + (size_t)l * 2 * 512};
            pg8::gemm_phase<EpiLU, pg8::StaticOrder, true, true, 128>(L + RING_OFF, g, S, E, tid);
        }
        SEAM(pb + P_GATES);
        if (IN(pb + P_AGG)) { PHASE_IDS();
            LAS float* SA = (LAS float*)(L + RING_OFF);
            for (int wu = bid; wu < (M / 256) * 4; wu += G) {
                const int bk = wu >> 2, ci = bk * 8 + wave, c0 = (wu & 3) * 128 + 2 * lane;
                float Af[2] = {1.f, 1.f}, Hf[2] = {0.f, 0.f}, Pb[2] = {1.f, 1.f}, Hb[2] = {0.f, 0.f};
                const bf16* lp = GATES + ((size_t)ci * LCH * LRU_W + c0) * 4;
#pragma unroll
                for (int hh = 0; hh < 2; ++hh) {
                    v4u w[16];
#pragma unroll
                    for (int t = 0; t < 16; ++t) w[t] = *(const v4u*)(lp + (size_t)(hh * 16 + t) * (LRU_W * 4));
#pragma unroll
                    for (int t = 0; t < 16; ++t) {
                        float a;
                        a = __builtin_amdgcn_exp2f(bflo(w[t].x)); Hf[0] = a * Hf[0] + bfhi(w[t].x); Af[0] *= a;
                        a = __builtin_amdgcn_exp2f(bflo(w[t].z)); Hf[1] = a * Hf[1] + bfhi(w[t].z); Af[1] *= a;
                        a = __builtin_amdgcn_exp2f(bflo(w[t].y)); Hb[0] += Pb[0] * bfhi(w[t].y); Pb[0] *= a;
                        a = __builtin_amdgcn_exp2f(bflo(w[t].w)); Hb[1] += Pb[1] * bfhi(w[t].w); Pb[1] *= a;
                    }
                }
                { LAS f32x4* s4 = (LAS f32x4*)(SA + (wave * 64 + lane) * 8); s4[0] = (f32x4){Af[0], Hf[0], Af[1], Hf[1]}; s4[1] = (f32x4){Pb[0], Hb[0], Pb[1], Hb[1]}; }
                __syncthreads();
                float Alf[2] = {1.f, 1.f}, Hlf[2] = {0.f, 0.f}, Alb[2] = {1.f, 1.f}, Hlb[2] = {0.f, 0.f};
                for (int j = 0; j < wave; ++j) { const f32x4 v = *(const LAS f32x4*)(SA + (j * 64 + lane) * 8);
                    Hlf[0] = v.x * Hlf[0] + v.y; Alf[0] *= v.x; Hlf[1] = v.z * Hlf[1] + v.w; Alf[1] *= v.z; }
                for (int j = 7; j > wave; --j) { const f32x4 v = *(const LAS f32x4*)(SA + (j * 64 + lane) * 8 + 4);
                    Hlb[0] = v.x * Hlb[0] + v.y; Alb[0] *= v.x; Hlb[1] = v.z * Hlb[1] + v.w; Alb[1] *= v.z; }
                *(f32x4*)(AGG + ((size_t)(ci * 2 + 0) * 512 + c0) * 2) = (f32x4){Alf[0], Hlf[0], Alf[1], Hlf[1]};
                *(f32x4*)(AGG + ((size_t)(ci * 2 + 1) * 512 + c0) * 2) = (f32x4){Alb[0], Hlb[0], Alb[1], Hlb[1]};
                const int sq = bk < 128 ? (bk >> 4) : 8, bis = bk < 128 ? (bk & 15) : bk - 128;
                if (wave == 7) {
#pragma unroll
                    for (int e = 0; e < 2; ++e) *(float2*)(BAGG + (((size_t)(sq * 2 + 0) * 512 + c0 + e) * 64 + bis) * 2) = make_float2(Af[e] * Alf[e], Af[e] * Hlf[e] + Hf[e]);
                }
                if (wave == 0) {
#pragma unroll
                    for (int e = 0; e < 2; ++e) *(float2*)(BAGG + (((size_t)(sq * 2 + 1) * 512 + c0 + e) * 64 + bis) * 2) = make_float2(Pb[e] * Alb[e], Pb[e] * Hlb[e] + Hb[e]);
                }
                __syncthreads();
            }
        }
        SEAM(pb + P_AGG);
        if (IN(pb + P_CARRY)) { PHASE_IDS();
            for (int id = gw; id < NSEQ * 2 * 512; id += NGW) {
                const int dr = (id >> 9) & 1, s = id >> 10, nb = s < NB_P ? SEQ_P / 256 : SEQ_S / 256;
                const int blk = dr ? nb - 1 - lane : lane; const bool ok = lane < nb;
                float A = 1.f, H = 0.f;
                if (ok) { const float2 ah = *(const float2*)(BAGG + ((size_t)id * 64 + blk) * 2); A = ah.x; H = ah.y; }
#pragma unroll
                for (int off = 1; off < 64; off <<= 1) { const int src = ((lane - off) & 63) << 2;
                    const float Ap = __builtin_bit_cast(float, __builtin_amdgcn_ds_bpermute(src, __builtin_bit_cast(int, A))), Hp = __builtin_bit_cast(float, __builtin_amdgcn_ds_bpermute(src, __builtin_bit_cast(int, H)));
                    if (lane >= off) { H = A * Hp + H; A = A * Ap; } }
                const float cin = __builtin_bit_cast(float, __builtin_amdgcn_ds_bpermute(((lane - 1) & 63) << 2, __builtin_bit_cast(int, H)));
                if (ok) BC[(size_t)id * 64 + blk] = lane == 0 ? 0.f : cin;
            }
        }
        SEAM(pb + P_CARRY);
        if (IN(pb + P_LRU)) { PHASE_IDS();
            for (int u = gw; u < NCHK * 4; u += NGW) {
                const int ci = u >> 2, c0 = (u & 3) * 128 + 2 * lane;
                const int bk = ci >> 3, sq = bk < 128 ? (bk >> 4) : 8, bis = bk < 128 ? (bk & 15) : bk - 128;
                const f32x4 lf = *(const f32x4*)(AGG + ((size_t)(ci * 2 + 0) * 512 + c0) * 2), lb = *(const f32x4*)(AGG + ((size_t)(ci * 2 + 1) * 512 + c0) * 2);
                float hf0 = lf.x * BC[((size_t)(sq * 2 + 0) * 512 + c0) * 64 + bis] + lf.y, hf1 = lf.z * BC[((size_t)(sq * 2 + 0) * 512 + c0 + 1) * 64 + bis] + lf.w;
                float hb0 = lb.x * BC[((size_t)(sq * 2 + 1) * 512 + c0) * 64 + bis] + lb.y, hb1 = lb.z * BC[((size_t)(sq * 2 + 1) * 512 + c0 + 1) * 64 + bis] + lb.w;
                const bf16* lp = GATES + ((size_t)ci * LCH * LRU_W + c0) * 4;
                const bf16* pp = PA + (size_t)ci * LCH * PA_W + C_GATE + c0; bf16* yp = YMIX + (size_t)ci * LCH * D + c0;
                float hv0[LCH], hv1[LCH]; v4u w[LCH]; unsigned gt[LCH];
#pragma unroll
                for (int hh = 0; hh < 2; ++hh) {
#pragma unroll
                  for (int t = 0; t < 16; ++t) { const int tt = hh * 16 + t; w[tt] = __builtin_nontemporal_load((const v4u*)(lp + (size_t)tt * (LRU_W * 4))); gt[tt] = *(const unsigned*)(pp + (size_t)tt * PA_W); }
#pragma unroll
                  for (int t = 0; t < 16; ++t) { const int tt = hh * 16 + t; float a;
                    a = __builtin_amdgcn_exp2f(bflo(w[tt].x)); hf0 = a * hf0 + bfhi(w[tt].x); hv0[tt] = hf0;
                    a = __builtin_amdgcn_exp2f(bflo(w[tt].z)); hf1 = a * hf1 + bfhi(w[tt].z); hv1[tt] = hf1; } }
#pragma unroll
                for (int tt = LCH - 1; tt >= 0; --tt) { float a;
                    a = __builtin_amdgcn_exp2f(bflo(w[tt].y)); hb0 = a * hb0 + bfhi(w[tt].y);
                    a = __builtin_amdgcn_exp2f(bflo(w[tt].w)); hb1 = a * hb1 + bfhi(w[tt].w);
                    *(unsigned*)(yp + (size_t)tt * D) = pk2((hv0[tt] + hb0) * fgelu(bflo(gt[tt])), (hv1[tt] + hb1) * fgelu(bfhi(gt[tt]))); }
            }
        }
        SEAM(pb + P_LRU);
        if (IN(pb + P_ATT)) { PHASE_IDS();
            LAS unsigned char* wl = L + RING_OFF + wave * 16384;
            const int vcu = (G % 8 == 0) ? (bid % 8) * (G / 8) + bid / 8 : bid;
            MakeAtt mk{HB, YMIX, YBUF  , (float*)(YBUF + (size_t)2 * M * 768)  , args.in[14] + l * 6};
            attn_stream<true, MakeAtt>(mk, vcu * NWAVES + wave, 24 * (M / 32), NGW, wl, lane);
        }
        SEAM(pb + P_ATT);
        if (IN(pb + P_COMB)) { PHASE_IDS();
            const float* gn = args.in[15] + (size_t)l * D;
            const bf16* OP23 = YBUF; const float* STATS = (const float*)(YBUF + (size_t)2 * M * 768);
            const int half = lane >> 5, ci = (lane & 31) * 4;
            f32x4 gB[3], gC[3], gA0, gA1;
#pragma unroll
            for (int j = 0; j < 3; ++j) { gB[j] = *(const f32x4*)(gn + 512 + (2 * j + half) * HD + ci); gC[j] = *(const f32x4*)(gn + 1280 + (2 * j + half) * HD + ci); }
            gA0 = *(const f32x4*)(gn + 8 * lane); gA1 = *(const f32x4*)(gn + 8 * lane + 4);
#define COMB_LOAD(mm, A_, B_, C_, E_, S1_, S2_, S3_, WA_) do { const bf16* yr_ = YMIX + (size_t)(mm) * D; \
                _Pragma("unroll") for (int j = 0; j < 3; ++j) { const int hh = 2 * j + half; \
                    A_[j] = *(const v2u*)(yr_ + 512 + hh * HD + ci); B_[j] = *(const v2u*)(OP23 + (size_t)(mm) * 768 + hh * HD + ci); \
                    C_[j] = *(const v2u*)(OP23 + (size_t)M * 768 + (size_t)(mm) * 768 + hh * HD + ci); E_[j] = *(const v2u*)(yr_ + 1280 + hh * HD + ci); \
                    const float* st = STATS + ((size_t)(mm) * 6 + hh) * 6; S1_[j] = *(const float2*)st; S2_[j] = *(const float2*)(st + 2); S3_[j] = *(const float2*)(st + 4); } \
                WA_ = *(const v4u*)(yr_ + 8 * lane); } while (0)
            v2u a[3], b[3], c[3], e[3]; float2 s1[3], s2[3], s3[3]; v4u wa = (v4u){0u, 0u, 0u, 0u};
#pragma unroll
            for (int j = 0; j < 3; ++j) { a[j] = b[j] = c[j] = e[j] = (v2u){0u, 0u}; s1[j] = s2[j] = s3[j] = make_float2(0.f, 1.f); }
            if (gw < M) COMB_LOAD(gw, a, b, c, e, s1, s2, s3, wa);
            for (int m = gw; m < M; m += NGW) {
                bf16* yrow = YMIX + (size_t)m * D;
                const int mn = m + NGW;
                v2u an[3], bn[3], cn[3], en[3]; float2 s1n[3], s2n[3], s3n[3]; v4u wan = (v4u){0u, 0u, 0u, 0u};
#pragma unroll
                for (int j = 0; j < 3; ++j) { an[j] = bn[j] = cn[j] = en[j] = (v2u){0u, 0u}; s1n[j] = s2n[j] = s3n[j] = make_float2(0.f, 1.f); }
                if (mn < M) COMB_LOAD(mn, an, bn, cn, en, s1n, s2n, s3n, wan);
                float vb[3][4], vc[3][4]; float ssb = 0.f, ssc = 0.f;
#pragma unroll
                for (int j = 0; j < 3; ++j) {
                    const float mm = fmaxf(s1[j].x, fmaxf(s2[j].x, s3[j].x));
                    const float w1 = s1[j].y * __builtin_amdgcn_exp2f(s1[j].x - mm), w2 = s2[j].y * __builtin_amdgcn_exp2f(s2[j].x - mm), w3 = s3[j].y * __builtin_amdgcn_exp2f(s3[j].x - mm);
                    const float inv = __builtin_amdgcn_rcpf(w1 + w2 + w3);
                    const float u1 = w1 * inv, u2 = w2 * inv, u3 = w3 * inv;
                    vb[j][0] = u1 * bflo(a[j].x) + u2 * bflo(b[j].x) + u3 * bflo(c[j].x); vb[j][1] = u1 * bfhi(a[j].x) + u2 * bfhi(b[j].x) + u3 * bfhi(c[j].x);
                    vb[j][2] = u1 * bflo(a[j].y) + u2 * bflo(b[j].y) + u3 * bflo(c[j].y); vb[j][3] = u1 * bfhi(a[j].y) + u2 * bfhi(b[j].y) + u3 * bfhi(c[j].y);
                    vc[j][0] = bflo(e[j].x); vc[j][1] = bfhi(e[j].x); vc[j][2] = bflo(e[j].y); vc[j][3] = bfhi(e[j].y);
#pragma unroll
                    for (int q = 0; q < 4; ++q) { ssb += vb[j][q] * vb[j][q]; ssc += vc[j][q] * vc[j][q]; }
                }
                float y[8] = {bflo(wa.x), bfhi(wa.x), bflo(wa.y), bfhi(wa.y), bflo(wa.z), bfhi(wa.z), bflo(wa.w), bfhi(wa.w)}; float ssa = 0.f;
#pragma unroll
                for (int q = 0; q < 8; ++q) ssa += y[q] * y[q];
                const float rb = rsqrtf(wave_sum_fast(ssb) * (1.f / 768.f) + EPS), rc = rsqrtf(wave_sum_fast(ssc) * (1.f / 768.f) + EPS), ra = rsqrtf(wave_sum_fast(ssa) * (1.f / 512.f) + EPS);
                { v4u o; o.x = cvtpk_s(y[0] * ra * gA0.x, y[1] * ra * gA0.y); o.y = cvtpk_s(y[2] * ra * gA0.z, y[3] * ra * gA0.w); o.z = cvtpk_s(y[4] * ra * gA1.x, y[5] * ra * gA1.y); o.w = cvtpk_s(y[6] * ra * gA1.z, y[7] * ra * gA1.w);
                  *(v4u*)(yrow + 8 * lane) = o; }
#pragma unroll
                for (int j = 0; j < 3; ++j) { const int hh = 2 * j + half;
                    v2u ob, oc; ob.x = cvtpk_s(vb[j][0] * rb * gB[j].x, vb[j][1] * rb * gB[j].y); ob.y = cvtpk_s(vb[j][2] * rb * gB[j].z, vb[j][3] * rb * gB[j].w);
                    oc.x = cvtpk_s(vc[j][0] * rc * gC[j].x, vc[j][1] * rc * gC[j].y); oc.y = cvtpk_s(vc[j][2] * rc * gC[j].z, vc[j][3] * rc * gC[j].w);
                    *(v2u*)(yrow + 512 + hh * HD + ci) = ob; *(v2u*)(yrow + 1280 + hh * HD + ci) = oc; }
#pragma unroll
                for (int j = 0; j < 3; ++j) { a[j] = an[j]; b[j] = bn[j]; c[j] = cn[j]; e[j] = en[j]; s1[j] = s1n[j]; s2[j] = s2n[j]; s3[j] = s3n[j]; }
                wa = wan;
            }
#undef COMB_LOAD
        }
        SEAM(pb + P_COMB);
        if (IN(pb + P_WOUT)) { PHASE_IDS();
            pg8::Gemm g{YMIX, WOUT_T, M, D, D}; pg8::StaticOrder S; S.init(M, D, G, bid); pg8::EpiBf16<0> E{YBUF, D, nullptr};
            pg8::gemm_phase<pg8::EpiBf16<0>, pg8::StaticOrder, true, true>(L + RING_OFF, g, S, E, tid);
        }
        SEAM(pb + P_WOUT);
        if (IN(pb + P_ROW1)) { PHASE_IDS();
            rows_split<1>(nullptr, nullptr, XH, YBUF, args.in[5] + (size_t)l * D, RSTD, nullptr, gw, NGW, lane);
        }
        SEAM(pb + P_ROW1);
        if (IN(pb + P_MQ)) { PHASE_IDS();
            pg8::Gemm g{XH, WMQ_T, M, MEM_W, D}; pg8::StaticOrder S; S.init(M, MEM_W, G, bid); pg8::EpiBf16<0> E{QBUF, MEM_W, nullptr, nullptr};
            pg8::gemm_phase<pg8::EpiBf16<0>, pg8::StaticOrder, true, true>(L + RING_OFF, g, S, E, tid);
            if (G == 256 && bid >= 128) CONV_RANGE(N_EARLY + N_DEF_PROJ, NITEMS, (bid - 128) * NWAVES + wave, (256 - 128) * NWAVES);
        }
        SEAM(pb + P_MQ);
        if (IN(pb + P_XATT)) { PHASE_IDS();
            LAS unsigned char* wl = L + RING_OFF + wave * 16384;
            const int vcu = (G % 8 == 0) ? (bid % 8) * (G / 8) + bid / 8 : bid;
            MakeX mk{QBUF, MEMKV, OBUF};
            attn_stream<false, MakeX>(mk, vcu * NWAVES + wave, 4 * (M / 32), NGW, wl, lane);
        }
        SEAM(pb + P_XATT);
        if (IN(pb + P_MO)) { PHASE_IDS();
            pg8::Gemm g{OBUF, WMO_T, M, D, MEM_W}; pg8::StaticOrder S; S.init(M, D, G, bid); pg8::EpiBf16<0> E{YBUF, D, nullptr};
            pg8::gemm_phase<pg8::EpiBf16<0>, pg8::StaticOrder, true, true>(L + RING_OFF, g, S, E, tid);
        }
        SEAM(pb + P_MO);
        if (IN(pb + P_ROW2)) { PHASE_IDS();
            rows_split<1>(nullptr, nullptr, XH, YBUF, args.in[18] + (size_t)l * D, RSTD, nullptr, gw, NGW, lane);
        }
        SEAM(pb + P_ROW2);
        for (int c = 0; c < NFCH; ++c) {
            if (IN(pb + P_FF0 + 2 * c)) { PHASE_IDS();
                pg8::Gemm g{XH + (size_t)c * FCH * D, W1_T, FCH, DFF, D}; pg8::StaticOrder S; S.init(FCH, DFF, G, bid); pg8::EpiBf16<1> E{UBUF, DFF, nullptr, nullptr};
                pg8::gemm_phase<pg8::EpiBf16<1>, pg8::StaticOrder, true, true>(L + RING_OFF, g, S, E, tid);
            }
            SEAM(pb + P_FF0 + 2 * c);
            if (IN(pb + P_FF1 + 2 * c)) { PHASE_IDS();
                pg8::Gemm g{UBUF, W2_T, FCH, D, DFF}; pg8::StaticOrder S; S.init(FCH, D, G, bid); pg8::EpiBf16<0> E{YBUF + (size_t)c * FCH * D, D, nullptr};
                pg8::gemm_phase<pg8::EpiBf16<0>, pg8::StaticOrder, true, true>(L + RING_OFF, g, S, E, tid);
            }
            SEAM(pb + P_FF1 + 2 * c);
        }
        if (IN(pb + P_ROW3)) { PHASE_IDS();
            const bool nxt = (l + 1 < DEPTH);
            if (nxt) rows_split<1>(nullptr, nullptr, XH, YBUF, args.in[25] + (size_t)l * D, RSTD, nullptr, gw, NGW, lane);
            else rows_split<2>(nullptr, nullptr, XH, YBUF, args.in[25] + (size_t)l * D, RSTD, X, gw, NGW, lane);
        }
        SEAM(pb + P_ROW3);
    }
#undef IN
#undef SEAM
}

extern "C" void kernel_launch(void* const* d_in, const int* in_sizes, int n_in, void* d_out, int out_size, void* d_ws, size_t ws_size, hipStream_t stream) {
    static int grid = 0;
    if (grid == 0) {
        if (n_in != 28 || out_size != M * D || ws_size < WS_END) { fprintf(stderr, "kernel_launch: unexpected shapes (n_in %d out %d ws %zu)\n", n_in, out_size, ws_size); grid = -1; return; }
        int dev = 0, cus = 0, per_cu = 0;
        if (hipGetDevice(&dev) != hipSuccess || hipDeviceGetAttribute(&cus, hipDeviceAttributeMultiprocessorCount, dev) != hipSuccess) { grid = -1; return; }
        if (hipFuncSetAttribute((const void*)trunk_fwd, hipFuncAttributeMaxDynamicSharedMemorySize, LDS_BYTES) != hipSuccess) { grid = -1; return; }
        if (hipOccupancyMaxActiveBlocksPerMultiprocessor(&per_cu, (const void*)trunk_fwd, NWAVES * 64, LDS_BYTES) != hipSuccess || per_cu < 1) { fprintf(stderr, "kernel_launch: occupancy query says %d\n", per_cu); }
        (void)hipGetLastError();
        grid = cus;
    }
    if (grid < 0) return;
    (void)in_sizes;
    if (hipMemsetAsync((char*)d_ws + WS_CTL, 0, CTL_ZERO_BYTES, stream) != hipSuccess) return;
    Args a{};
    for (int i = 0; i < 28; ++i) a.in[i] = (const float*)d_in[i];
    a.out = (float*)d_out; a.ws = (unsigned char*)d_ws;
    a.ph_lo = 0; a.ph_hi = NPHASES; a.mask = (1 << NP) - 1; a.sync = 1;
    hipLaunchKernelGGL(trunk_fwd, dim3(grid), dim3(NWAVES * 64), LDS_BYTES, stream, a);
#if defined(PROBE_MASK)
    a.out = (float*)((unsigned char*)d_ws + WS_PROJ); a.ph_lo = PROBE_LAYER * NP; a.ph_hi = PROBE_LAYER * NP + NP; a.mask = PROBE_MASK; a.sync = 0;
    for (int r = 0; r < PROBE_REPS; ++r) hipLaunchKernelGGL(trunk_fwd, dim3(grid), dim3(NWAVES * 64), LDS_BYTES, stream, a);
#endif
}
```
